# Optimizing an MI355X kernel written in HIP

```python
import jax, jax.numpy as jnp
from jax import lax
import numpy as np

D_MODEL = 1024
BATCH = 4
SEQ = 4096
DEPTH = 4

GRID_W = 64
CTX_LEN = 256
N_MIXERS = 3
RW_HEAD = 64
RW_HEADS = D_MODEL // RW_HEAD
RW_DECAY_LORA = 64
RW_AAA_LORA = 64
RW_GATE_LORA = 128
AT_HEAD = 128
AT_Q_HEADS = D_MODEL // AT_HEAD
AT_KV_HEADS = 2
Q_BLOCK = 128
ROPE_BASE = 10000.0
NA_HEAD = 64
NA_HEADS = D_MODEL // NA_HEAD
WIN_H = 8
WIN_W = 16
D_FF = -(-8 * D_MODEL // (3 * 256)) * 256
N_RWKV = len(range(0, DEPTH, N_MIXERS))
N_GQA = len(range(1, DEPTH, N_MIXERS))
N_NA = len(range(2, DEPTH, N_MIXERS))
RMS_EPS = 1e-6
LNX_EPS = 64e-5
NORM_EPS = 1e-12

kernel_name = "hybrid_rwkv7_gqa_natten_prefix_dit"


def rms_norm(x, g):
    xf = x.astype(jnp.float32)
    y = xf * lax.rsqrt(jnp.mean(xf * xf, axis=-1, keepdims=True) + RMS_EPS)
    return (y * g).astype(x.dtype)


def swiglu(h, w1, w3, w2):
    return (jax.nn.silu(h @ w1) * (h @ w3)) @ w2


def softmax_attend(q, k, v):
    s = jnp.einsum('bkgqd,bksd->bkgqs', q, k).astype(jnp.float32) * (q.shape[-1] ** -0.5)
    p = jax.nn.softmax(s, axis=-1).astype(v.dtype)
    return jnp.einsum('bkgqs,bksd->bkgqd', p, v)


def axial_rope(n_tok, head_dim):
    t = jnp.arange(n_tok)
    rows = (t // GRID_W).astype(jnp.float32)
    cols = (t % GRID_W).astype(jnp.float32)
    d_axis = head_dim // 2
    inv = jnp.float32(ROPE_BASE) ** (-jnp.arange(0, d_axis, 2, dtype=jnp.float32) / d_axis)
    ang = jnp.concatenate([rows[:, None] * inv, cols[:, None] * inv], axis=-1)
    return jnp.cos(ang), jnp.sin(ang)


def apply_rope(x, cos, sin):
    xp = x.reshape(x.shape[:-1] + (-1, 2))
    x1, x2 = xp[..., 0], xp[..., 1]
    c, s = cos[None, :, None, :], sin[None, :, None, :]
    out = jnp.stack([x1 * c - x2 * s, x1 * s + x2 * c], axis=-1)
    return out.reshape(x.shape).astype(x.dtype)


def centred_shift(h):
    prev = jnp.pad(h[:, :-1], ((0, 0), (1, 0), (0, 0)))
    nxt = jnp.pad(h[:, 1:], ((0, 0), (0, 1), (0, 0)))
    return 0.5 * (prev + nxt) - h


def _heads(t):
    return t.reshape(t.shape[:-1] + (RW_HEADS, RW_HEAD))


def rwkv7_features(h, mu, wr, wk, wv, w0, w1, w2, a0, a1, a2, k_k, k_a):
    f32 = jnp.float32
    xx = centred_shift(h)
    xr, xw, xk, xv, xa = (h + xx * mu[i] for i in range(5))
    r = _heads(xr @ wr)
    k = _heads(xk @ wk)
    v = _heads(xv @ wv)
    kk = (k * _heads(k_k)).astype(f32)
    kk = kk / jnp.maximum(jnp.linalg.norm(kk, axis=-1, keepdims=True), NORM_EPS)
    lora_w = jnp.einsum('ebtr,erd->ebtd', jnp.tanh(jnp.einsum('btd,edr->ebtr', xw, w1)), w2)
    w_log = -jax.nn.softplus(-(w0[:, None, None, :] + lora_w).astype(f32)) - 0.5
    decay = _heads(jnp.exp(-jnp.exp(w_log)))
    lora_a = jnp.einsum('ebtr,erd->ebtd', jnp.einsum('btd,edr->ebtr', xa, a1), a2)
    a = _heads(jax.nn.sigmoid((a0[:, None, None, :] + lora_a).astype(f32)))
    k_dir = k[None] * (1.0 + (a - 1.0) * _heads(k_a))
    return xx, r, v, kk, decay, a, k_dir


def rwkv7_scan(S0, r, decay, k, v, kk, a, reverse):
    def step(S, inp):
        r_t, w_t, k_t, v_t, kk_t, a_t = inp
        sa = jnp.einsum('bhvk,bhk->bhv', S, -kk_t)
        S = (S * w_t[:, :, None, :] + sa[..., None] * (kk_t * a_t)[:, :, None, :]
             + v_t[..., None] * k_t[:, :, None, :])
        return S, jnp.einsum('bhvk,bhk->bhv', S, r_t)
    xs = tuple(jnp.moveaxis(t.astype(jnp.float32), 1, 0) for t in (r, decay, k, v, kk, a))
    S, ys = lax.scan(step, S0, xs, reverse=reverse)
    return S, jnp.moveaxis(ys, 0, 1)


def rwkv7_mixer(h_lat, h_ctx, mu, wr, wk, wv, wo, w0, w1, w2, a0, a1, a2, g1, g2,
                k_k, k_a, r_k, lnx_g, lnx_b, need_ctx):
    feat_l = rwkv7_features(h_lat, mu, wr, wk, wv, w0, w1, w2, a0, a1, a2, k_k, k_a)
    feat_c = rwkv7_features(h_ctx, mu, wr, wk, wv, w0, w1, w2, a0, a1, a2, k_k, k_a)
    xx_l, r_l, v_l, kk_l, d_l, a_l, k_l = feat_l
    xx_c, r_c, v_c, kk_c, d_c, a_c, k_c = feat_c
    S0 = jnp.zeros((h_lat.shape[0], RW_HEADS, RW_HEAD, RW_HEAD), jnp.float32)
    ys_l, ys_c = [], []
    for d, rev in enumerate((False, True)):
        S_c, yc_d = rwkv7_scan(S0, r_c, d_c[d], k_c[d], v_c, kk_c, a_c[d], rev)
        _, yl_d = rwkv7_scan(S_c, r_l, d_l[d], k_l[d], v_l, kk_l, a_l[d], rev)
        ys_l.append(yl_d)
        ys_c.append(yc_d)

    def readout(h, xx, y, r, k_dir, v):
        B, T, D = h.shape
        mean = jnp.mean(y, axis=-1, keepdims=True)
        var = jnp.mean(jnp.square(y - mean), axis=-1, keepdims=True)
        yn = ((y - mean) * lax.rsqrt(var + LNX_EPS)).reshape(B, T, D) * lnx_g + lnx_b
        bonus = jnp.sum(jnp.sum(r[None] * k_dir * r_k, axis=-1, keepdims=True) * v[None], axis=0)
        g = jax.nn.sigmoid((h + xx * mu[5]) @ g1) @ g2
        return ((yn + bonus.reshape(B, T, D)) * g).astype(h.dtype) @ wo

    o_lat = readout(h_lat, xx_l, ys_l[0] + ys_l[1], r_l, k_l, v_l)
    o_ctx = readout(h_ctx, xx_c, ys_c[0] + ys_c[1], r_c, k_c, v_c) if need_ctx else None
    return o_lat, o_ctx


def gqa_mixer(h_lat, h_ctx, wq, wk, wv, wo, gq, gk, need_ctx):
    B, T, _ = h_lat.shape
    G = AT_Q_HEADS // AT_KV_HEADS

    def proj(h):
        n = h.shape[1]
        q = rms_norm((h @ wq).reshape(B, n, AT_Q_HEADS, AT_HEAD), gq)
        k = rms_norm((h @ wk).reshape(B, n, AT_KV_HEADS, AT_HEAD), gk)
        v = (h @ wv).reshape(B, n, AT_KV_HEADS, AT_HEAD)
        return q, k, v

    def to_groups(q):
        return q.reshape(B, q.shape[1], AT_KV_HEADS, G, AT_HEAD).transpose(0, 2, 3, 1, 4)

    def from_groups(o):
        return o.transpose(0, 3, 1, 2, 4).reshape(B, o.shape[3], AT_Q_HEADS * AT_HEAD)

    q_l, k_l, v_l = proj(h_lat)
    q_c, k_c, v_c = proj(h_ctx)
    cos, sin = axial_rope(T, AT_HEAD)
    q_l = apply_rope(q_l, cos, sin)
    k_l = apply_rope(k_l, cos, sin)
    k_all = jnp.concatenate([k_l, k_c], axis=1).transpose(0, 2, 1, 3)
    v_all = jnp.concatenate([v_l, v_c], axis=1).transpose(0, 2, 1, 3)
    nb = T // Q_BLOCK
    qb = to_groups(q_l).reshape(B, AT_KV_HEADS, G, nb, Q_BLOCK, AT_HEAD).transpose(3, 0, 1, 2, 4, 5)
    ob = lax.map(lambda q: softmax_attend(q, k_all, v_all), qb)
    o_l = ob.transpose(1, 2, 3, 0, 4, 5).reshape(B, AT_KV_HEADS, G, T, AT_HEAD)
    o_lat = from_groups(o_l) @ wo
    o_ctx = None
    if need_ctx:
        o_c = softmax_attend(to_groups(q_c), k_c.transpose(0, 2, 1, 3), v_c.transpose(0, 2, 1, 3))
        o_ctx = from_groups(o_c) @ wo
    return o_lat, o_ctx


def na_mixer(h_lat, h_ctx, wqkv, wo, gq, gk, rpb, need_ctx):
    B, T, _ = h_lat.shape
    rows = T // GRID_W
    kh, kw = min(WIN_H, rows), WIN_W
    n_win = kh * kw

    def proj(h):
        qkv = (h @ wqkv).reshape(B, h.shape[1], 3, NA_HEADS, NA_HEAD)
        q = rms_norm(qkv[:, :, 0], gq).transpose(0, 2, 1, 3)
        k = rms_norm(qkv[:, :, 1], gk).transpose(0, 2, 1, 3)
        v = qkv[:, :, 2].transpose(0, 2, 1, 3)
        return q, k, v

    q_l, k_l, v_l = proj(h_lat)
    q_c, k_c, v_c = proj(h_ctx)
    r_idx = np.arange(rows)
    c_idx = np.arange(GRID_W)
    key_rows = np.clip(r_idx - kh // 2, 0, rows - kh)[:, None] + np.arange(kh)
    key_cols = np.clip(c_idx - kw // 2, 0, GRID_W - kw)[:, None] + np.arange(kw)
    idx = (key_rows[:, None, :, None] * GRID_W + key_cols[None, :, None, :]).reshape(rows, GRID_W, n_win)
    off_r = jnp.asarray(key_rows - r_idx[:, None] + (WIN_H - 1), jnp.int32)
    off_c = jnp.asarray(key_cols - c_idx[:, None] + (WIN_W - 1), jnp.int32)
    idx = jnp.asarray(idx, jnp.int32)
    scale = NA_HEAD ** -0.5
    q_rows = q_l.reshape(B, NA_HEADS, rows, GRID_W, NA_HEAD).transpose(2, 0, 1, 3, 4)

    def row_block(args):
        q_row, idx_row, offr_row = args
        k_win = k_l[:, :, idx_row]
        v_win = v_l[:, :, idx_row]
        bias = rpb[:, offr_row[None, :, None], off_c[:, None, :]].reshape(NA_HEADS, GRID_W, n_win)
        s_win = jnp.einsum('bhqd,bhqkd->bhqk', q_row, k_win).astype(jnp.float32) * scale + bias
        s_ctx = jnp.einsum('bhqd,bhcd->bhqc', q_row, k_c).astype(jnp.float32) * scale
        p = jax.nn.softmax(jnp.concatenate([s_win, s_ctx], axis=-1), axis=-1).astype(v_l.dtype)
        return (jnp.einsum('bhqk,bhqkd->bhqd', p[..., :n_win], v_win)
                + jnp.einsum('bhqc,bhcd->bhqd', p[..., n_win:], v_c))

    o = lax.map(row_block, (q_rows, idx, off_r))
    o_lat = o.transpose(1, 0, 3, 2, 4).reshape(B, T, NA_HEADS * NA_HEAD) @ wo
    o_ctx = None
    if need_ctx:
        o_c = softmax_attend(q_c[:, :, None], k_c, v_c)[:, :, 0]
        o_ctx = o_c.transpose(0, 2, 1, 3).reshape(B, h_ctx.shape[1], NA_HEADS * NA_HEAD) @ wo
    return o_lat, o_ctx


def setup_inputs(seed: int = 0) -> dict:
    key = jax.random.key(seed)
    keys = iter(jax.random.split(key, 64))
    f32 = jnp.float32
    D = D_MODEL
    nA, nB, nC = N_RWKV, N_GQA, N_NA
    A_DIM = AT_Q_HEADS * AT_HEAD
    KV_DIM = AT_KV_HEADS * AT_HEAD
    N_DIM = NA_HEADS * NA_HEAD

    def nrm(shape, std):
        return jax.random.normal(next(keys), shape, f32) * std

    def unif(shape, lo, hi):
        return jax.random.uniform(next(keys), shape, f32, lo, hi)

    return {
        "x": nrm((BATCH, SEQ, D), 1.0),
        "c": nrm((BATCH, D), 1.0),
        "ctx": nrm((BATCH, CTX_LEN, D), 1.0),
        "c_ctx": nrm((D,), 1.0),
        "mod_w": nrm((DEPTH, D, 6 * D), 0.5 * D ** -0.5),
        "mod_b": nrm((DEPTH, 6 * D), 0.02),
        "norm_mix": 1.0 + nrm((DEPTH, D), 0.05),
        "norm_ffn": 1.0 + nrm((DEPTH, D), 0.05),
        "ff_w1": nrm((DEPTH, D, D_FF), D ** -0.5),
        "ff_w3": nrm((DEPTH, D, D_FF), D ** -0.5),
        "ff_w2": nrm((DEPTH, D_FF, D), D_FF ** -0.5),
        "rw_mu": unif((nA, 6, D), 0.0, 1.0),
        "rw_wr": nrm((nA, D, D), D ** -0.5),
        "rw_wk": nrm((nA, D, D), D ** -0.5),
        "rw_wv": nrm((nA, D, D), D ** -0.5),
        "rw_wo": nrm((nA, D, D), D ** -0.5),
        "rw_w0": unif((nA, 2, D), -5.0, 0.5),
        "rw_w1": nrm((nA, 2, D, RW_DECAY_LORA), D ** -0.5),
        "rw_w2": nrm((nA, 2, RW_DECAY_LORA, D), 0.5 * RW_DECAY_LORA ** -0.5),
        "rw_a0": nrm((nA, 2, D), 0.1),
        "rw_a1": nrm((nA, 2, D, RW_AAA_LORA), D ** -0.5),
        "rw_a2": nrm((nA, 2, RW_AAA_LORA, D), 0.5 * RW_AAA_LORA ** -0.5),
        "rw_g1": nrm((nA, D, RW_GATE_LORA), D ** -0.5),
        "rw_g2": nrm((nA, RW_GATE_LORA, D), RW_GATE_LORA ** -0.5),
        "rw_kk": 0.85 + nrm((nA, D), 0.05),
        "rw_ka": 1.0 + nrm((nA, D), 0.05),
        "rw_rk": nrm((nA, RW_HEADS, RW_HEAD), 0.1),
        "rw_lnx_g": 1.0 + nrm((nA, D), 0.05),
        "rw_lnx_b": nrm((nA, D), 0.02),
        "at_wq": nrm((nB, D, A_DIM), D ** -0.5),
        "at_wk": nrm((nB, D, KV_DIM), D ** -0.5),
        "at_wv": nrm((nB, D, KV_DIM), D ** -0.5),
        "at_wo": nrm((nB, A_DIM, D), A_DIM ** -0.5),
        "at_gq": 1.0 + nrm((nB, AT_HEAD), 0.05),
        "at_gk": 1.0 + nrm((nB, AT_HEAD), 0.05),
        "na_wqkv": nrm((nC, D, 3 * N_DIM), D ** -0.5),
        "na_wo": nrm((nC, N_DIM, D), N_DIM ** -0.5),
        "na_gq": 1.0 + nrm((nC, NA_HEAD), 0.05),
        "na_gk": 1.0 + nrm((nC, NA_HEAD), 0.05),
        "na_rpb": nrm((nC, NA_HEADS, 2 * WIN_H - 1, 2 * WIN_W - 1), 0.1),
    }


def reference(x, c, ctx, c_ctx, mod_w, mod_b, norm_mix, norm_ffn, ff_w1, ff_w3, ff_w2,
              rw_mu, rw_wr, rw_wk, rw_wv, rw_wo, rw_w0, rw_w1, rw_w2, rw_a0, rw_a1, rw_a2,
              rw_g1, rw_g2, rw_kk, rw_ka, rw_rk, rw_lnx_g, rw_lnx_b,
              at_wq, at_wk, at_wv, at_wo, at_gq, at_gk,
              na_wqkv, na_wo, na_gq, na_gk, na_rpb):
    mod_lat = jnp.einsum('bd,lde->lbe', jax.nn.silu(c), mod_w) + mod_b[:, None, :]
    mod_ctx = jnp.einsum('d,lde->le', jax.nn.silu(c_ctx), mod_w) + mod_b
    h_lat, h_ctx = x, ctx
    for i in range(DEPTH):
        need_ctx = i < DEPTH - 1
        kind, j = i % N_MIXERS, i // N_MIXERS
        sh_m, sc_m, gt_m, sh_f, sc_f, gt_f = jnp.split(mod_lat[i][:, None, :], 6, axis=-1)
        csh_m, csc_m, cgt_m, csh_f, csc_f, cgt_f = jnp.split(mod_ctx[i], 6, axis=-1)
        a_lat = rms_norm(h_lat, norm_mix[i]) * (1.0 + sc_m) + sh_m
        a_ctx = rms_norm(h_ctx, norm_mix[i]) * (1.0 + csc_m) + csh_m
        if kind == 0:
            o_lat, o_ctx = rwkv7_mixer(a_lat, a_ctx, rw_mu[j], rw_wr[j], rw_wk[j], rw_wv[j], rw_wo[j],
                                       rw_w0[j], rw_w1[j], rw_w2[j], rw_a0[j], rw_a1[j], rw_a2[j],
                                       rw_g1[j], rw_g2[j], rw_kk[j], rw_ka[j], rw_rk[j],
                                       rw_lnx_g[j], rw_lnx_b[j], need_ctx)
        elif kind == 1:
            o_lat, o_ctx = gqa_mixer(a_lat, a_ctx, at_wq[j], at_wk[j], at_wv[j], at_wo[j],
                                     at_gq[j], at_gk[j], need_ctx)
        else:
            o_lat, o_ctx = na_mixer(a_lat, a_ctx, na_wqkv[j], na_wo[j], na_gq[j], na_gk[j],
                                    na_rpb[j], need_ctx)
        h_lat = h_lat + gt_m * o_lat
        f_lat = rms_norm(h_lat, norm_ffn[i]) * (1.0 + sc_f) + sh_f
        h_lat = h_lat + gt_f * swiglu(f_lat, ff_w1[i], ff_w3[i], ff_w2[i])
        if need_ctx:
            h_ctx = h_ctx + cgt_m * o_ctx
            f_ctx = rms_norm(h_ctx, norm_ffn[i]) * (1.0 + csc_f) + csh_f
            h_ctx = h_ctx + cgt_f * swiglu(f_ctx, ff_w1[i], ff_w3[i], ff_w2[i])
    return h_lat
```

```cpp
#include <hip/hip_runtime.h>
#include <hip/hip_cooperative_groups.h>
#include <cstdio>
#include <cstdint>
namespace cg = cooperative_groups;
#ifndef ONE_LAUNCH
#define ONE_LAUNCH 1
#endif
#ifndef PROBE_KIND
#define PROBE_KIND 0
#endif
namespace pg8 {
#define PG8_LAS __attribute__((address_space(3)))
typedef unsigned short bf16_t;
typedef short bf16x8 __attribute__((ext_vector_type(8)));
typedef float f32x4 __attribute__((ext_vector_type(4)));
typedef unsigned u32x4 __attribute__((ext_vector_type(4)));
constexpr int BM = 256, BK = 64, HALF = 128, HTB = HALF * BK * 2  , STAGE_BYTES = 8 * HTB, NXCD = 8, WGM = 8;

__host__ __device__ __forceinline__ int lds_byte(int r, int c) { const int st = (r >> 4) * 2 + (c >> 5), rr = r & 15, cc = c & 31, ob = rr * 64 + cc * 2; return st * 1024 + (ob ^ (((ob >> 9) & 1) << 5)); }
__host__ __device__ __forceinline__ void stage_rc(int b, int& R, int& C) { const int st = b / 1024, sb = b % 1024, swz = sb ^ (((sb >> 9) & 1) << 5); R = (st >> 1) * 16 + swz / 64; C = (st & 1) * 32 + (swz % 64) / 2; }
__host__ __device__ __forceinline__ int perm32(int rho) { const int n = rho >> 4, i = rho & 15; return 8 * (i >> 2) + 4 * n + (i & 3); }

struct Unit { int pm, pn, k0, nt, split; long aoff; };
struct Gemm { const bf16_t* A; const bf16_t* Bt; int M, N, K, lda; };

struct StaticOrder {
    int nM, nN, nwg, G, c;
    __host__ __device__ void init(int M, int N, int G_, int c_) { nM = M / BM; nN = N / BM; nwg = nM * nN; G = G_; c = c_; }
    __host__ __device__ bool next(int i, Unit& u) const {
        const long L = (long)i * G + c; if (L >= nwg) return false;
        int wgid = (int)L; { const int q = nwg / NXCD, r = nwg % NXCD, xcd = wgid % NXCD, off = wgid / NXCD; wgid = (xcd < r ? xcd * (q + 1) : r * (q + 1) + (xcd - r) * q) + off; }
        const int nig = WGM * nN, gid = wgid / nig, fm = gid * WGM, gsz = (nM - fm) < WGM ? (nM - fm) : WGM;
        u.pm = fm + ((wgid % nig) % gsz); u.pn = (wgid % nig) / gsz; return true;
    }
    __device__ __forceinline__ void a_ready(const Unit&) const {}
    __device__ __forceinline__ void done(const Unit&) const {}
};

struct GenOrder {
    int nM, nN, nwg, G, c, mode, ntf, nsplit; long caoff, act;
    __host__ __device__ void init(int M, int N, int K, int G_, int c_, int mode_) { nM = M / BM; nN = N / BM; G = G_; c = c_; mode = mode_; ntf = K / BK; nsplit = K / 256;
        if (mode == 2 && nM > 64) { nM = 64; } else if (mode == 2) mode = 0; nwg = nM * nN; caoff = 0; act = 0; }
    __host__ __device__ bool next(int i, Unit& u) const {
        const long L = (long)i * G + c; u.k0 = 0; u.nt = ntf; u.split = 0; u.aoff = 0;
        if (L >= nwg) {
            if (mode != 2) return false;
            const int idx = (int)(L - nwg); if (idx >= 4 * nN * nsplit) return false;
            const int tile = idx / nsplit, ks = idx - tile * nsplit; u.pm = 64 + tile / nN; u.pn = tile % nN; u.k0 = ks * 256; u.nt = 4; u.split = 1; return true;
        }
        int wgid = (int)L; { const int q = nwg / NXCD, r = nwg % NXCD, xcd = wgid % NXCD, off = wgid / NXCD; wgid = (xcd < r ? xcd * (q + 1) : r * (q + 1) + (xcd - r) * q) + off; }
        const int nig = WGM * nN, gid = wgid / nig, fm = gid * WGM, gsz = (nM - fm) < WGM ? (nM - fm) : WGM;
        u.pm = fm + ((wgid % nig) % gsz); u.pn = (wgid % nig) / gsz;
        if (mode == 3) { const int rg = u.pn >> 2; u.k0 = rg < 4 ? 64 * rg : 256; u.nt = 2; }
        if (mode == 1) { const int gi = u.pn < 12 ? (u.pn >> 2) : (u.pn - 9); u.aoff = gi < 4 ? caoff + (long)gi * act : (long)(gi - 4) * act; }
        return true;
    }
    __device__ __forceinline__ void a_ready(const Unit&) const {}
    __device__ __forceinline__ void done(const Unit&) const {}
};
__device__ __forceinline__ unsigned cvt_pk_bf16(float lo, float hi) { unsigned r; asm volatile("v_cvt_pk_bf16_f32 %0, %1, %2" : "=v"(r) : "v"(lo), "v"(hi)); return r; }
typedef unsigned u32x2 __attribute__((ext_vector_type(2)));
__device__ __forceinline__ float fsigmoid(float x) { return __builtin_amdgcn_rcpf(1.0f + __expf(-x)); }
__device__ __forceinline__ float ftanh(float x) { return 1.0f - 2.0f * __builtin_amdgcn_rcpf(__expf(2.0f * x) + 1.0f); }
struct EpiStore {
    static constexpr bool PERM = true, AFTER_DRAIN = false;
    bf16_t* O; int ldc; int split_cols; size_t split_stride; bf16_t* Oalt; int talt; bf16_t* HL; int rw1;
    __device__ __forceinline__ void operator()(const f32x4 (&acc)[2][2][4][2], const Unit& u, int wr, int wc, int fr, int fq) const {
        const int row0 = u.pm * BM + wr * 64 + fr; int colt = u.pn * BM; bf16_t* base = O; int ld = ldc; int actsel = 0;
        if (rw1 && u.pn >= 12) { base = HL; ld = 384; colt = (u.pn - 12) * 128; actsel = u.pn - 11; }
        else if (split_cols) { const int t = colt / split_cols; colt -= t * split_cols; if (t == talt) base = Oalt; else base += (size_t)t * split_stride; }
        const int col0 = colt + wc * 32 + 8 * fq;
#pragma unroll
        for (int ai = 0; ai < 2; ++ai)
#pragma unroll
            for (int m = 0; m < 4; ++m) { bf16_t* rowp = base + (size_t)(row0 + ai * HALF + m * 16) * ld + col0;
#pragma unroll
                for (int bj = 0; bj < 2; ++bj) { f32x4 v0 = acc[ai][bj][m][0], v1 = acc[ai][bj][m][1];
                    if (actsel && bj == 1) continue;
                    if (actsel == 1 && bj == 0) {
#pragma unroll
                        for (int j = 0; j < 4; ++j) { v0[j] = ftanh(v0[j]); v1[j] = ftanh(v1[j]); } }
                    if (actsel == 3) {
#pragma unroll
                        for (int j = 0; j < 4; ++j) { v0[j] = fsigmoid(v0[j]); v1[j] = fsigmoid(v1[j]); } }
                    u32x4 w; w.x = cvt_pk_bf16(v0[0], v0[1]); w.y = cvt_pk_bf16(v0[2], v0[3]); w.z = cvt_pk_bf16(v1[0], v1[1]); w.w = cvt_pk_bf16(v1[2], v1[3]);
                    *(u32x4*)(rowp + bj * HALF) = w; } }
    }
};
struct EpiRes {
    static constexpr bool PERM = false, AFTER_DRAIN = false;
    const float* base_lat; const float* base_ctx; float* out; const float* gate; float* part;
    __device__ __forceinline__ void operator()(const f32x4 (&acc)[2][2][4][2], const Unit& u, int wr, int wc, int fr, int fq) const {
        const int bidx = u.pm < 64 ? (u.pm >> 4) : 4; const float* bs = u.pm < 64 ? base_lat : base_ctx; const float* g = gate + bidx * 6144;
        const int col0 = u.pn * BM + wc * 32 + 4 * fq;
#pragma unroll
        for (int bj = 0; bj < 2; ++bj)
#pragma unroll
            for (int n = 0; n < 2; ++n) { const f32x4 gv = *(const f32x4*)(g + col0 + bj * HALF + n * 16);
#pragma unroll
                for (int ai = 0; ai < 2; ++ai) {
#pragma unroll
                    for (int m = 0; m < 4; ++m) { const size_t off = (size_t)(u.pm * BM + ai * HALF + wr * 64 + m * 16 + fr) * 1024 + col0 + bj * HALF + n * 16;
                        if (u.split) { *(f32x4*)(part + (size_t)(u.k0 >> 8) * 1048576 + (off - (size_t)16384 * 1024)) = gv * acc[ai][bj][m][n]; }
                        else { const f32x4 b = *(const f32x4*)(bs + off); *(f32x4*)(out + off) = b + gv * acc[ai][bj][m][n]; } }
                    asm volatile("" ::: "memory"); } }
    }
};
struct EpiSwiglu {
    static constexpr bool PERM = true, AFTER_DRAIN = false;
    bf16_t* U; int ldu;
    __device__ __forceinline__ void operator()(const f32x4 (&acc)[2][2][4][2], const Unit& u, int wr, int wc, int fr, int fq) const {
        const int row0 = u.pm * BM + wr * 64 + fr; const int col0 = u.pn * 128 + wc * 16 + 4 * fq;
#pragma unroll
        for (int ai = 0; ai < 2; ++ai)
#pragma unroll
            for (int m = 0; m < 4; ++m) { bf16_t* rowp = U + (size_t)(row0 + ai * HALF + m * 16) * ldu + col0;
#pragma unroll
                for (int bj = 0; bj < 2; ++bj) { const f32x4 a = acc[ai][bj][m][0], b = acc[ai][bj][m][1]; f32x4 o;
#pragma unroll
                    for (int j = 0; j < 4; ++j) o[j] = a[j] * fsigmoid(a[j]) * b[j];
                    u32x2 w; w.x = cvt_pk_bf16(o[0], o[1]); w.y = cvt_pk_bf16(o[2], o[3]); *(u32x2*)(rowp + bj * 64) = w; } }
    }
};
template <class Epi, class Sched, bool ALIGN_EPI = false, bool SP2 = false>
__device__ __forceinline__ void gemm_phase(PG8_LAS unsigned char* lds, const Gemm g, const Sched& S, const Epi& E) {
    int tid_ = threadIdx.x; asm volatile("" : "+v"(tid_));
    const int tid = tid_, wid = __builtin_amdgcn_readfirstlane(tid >> 6), lane = tid & 63, wr = wid >> 2, wc = wid & 3, fr = lane & 15, fq = lane >> 4;
    const int K = g.K;
    unsigned voffA[2], voffB[2];
#pragma unroll
    for (int i = 0; i < 2; ++i) { int R, C; stage_rc(tid * 16 + i * 8192, R, C); const int Rb = Epi::PERM ? ((R & ~31) + perm32(R & 31)) : R;
        voffA[i] = (unsigned)(R * g.lda + C) * 2u; voffB[i] = (unsigned)(Rb * K + C) * 2u; }
    const size_t kstep = (size_t)(BK * 2);
    const size_t hstepB = (size_t)HALF * K * 2, hstepA = (size_t)HALF * g.lda * 2;
    const size_t tstepB = 2 * hstepB, tstepA = 2 * hstepA;
    const unsigned ldsw = (unsigned)wid * 1024u;
    const int aoff = lds_byte(wr * 64 + fr, fq * 8), boff = lds_byte(wc * 32 + fr, fq * 8);
#define PG8_SA(b, h) (((b) * 2 + (h)) * HTB)
#define PG8_SB(b, h) ((4 + (b) * 2 + (h)) * HTB)
#define PG8_STAGE(bufoff, gbase, voff) do { _Pragma("unroll") for (int _i = 0; _i < 2; ++_i) \
        __builtin_amdgcn_global_load_lds((const unsigned*)((const char*)(gbase) + (voff)[_i]), (PG8_LAS unsigned*)(lds + (bufoff) + ldsw + _i * 8192), 16, 0, 0); } while (0)
#define PG8_LDA(dst, b, h) do { _Pragma("unroll") for (int m = 0; m < 4; ++m) _Pragma("unroll") for (int k = 0; k < 2; ++k) dst[m][k] = *(const PG8_LAS bf16x8*)(lds + PG8_SA(b, h) + aoff + m * 2048 + k * 1024); } while (0)
#define PG8_LDB(dst, b, h) do { _Pragma("unroll") for (int n = 0; n < 2; ++n) _Pragma("unroll") for (int k = 0; k < 2; ++k) dst[n][k] = *(const PG8_LAS bf16x8*)(lds + PG8_SB(b, h) + boff + n * 2048 + k * 1024); } while (0)
#define PG8_MMA(ai, bj, At, Bt) do { __builtin_amdgcn_s_setprio(1); _Pragma("unroll") for (int m = 0; m < 4; ++m) _Pragma("unroll") for (int n = 0; n < 2; ++n) _Pragma("unroll") for (int k = 0; k < 2; ++k) \
        acc[ai][bj][m][n] = __builtin_amdgcn_mfma_f32_16x16x32_bf16(Bt[n][k], At[m][k], acc[ai][bj][m][n], 0, 0, 0); __builtin_amdgcn_s_setprio(0); } while (0)
#define PG8_WAIT_V(n) asm volatile("s_waitcnt vmcnt(" #n ")" ::: "memory")
#define PG8_WAIT_L(n) asm volatile("s_waitcnt lgkmcnt(" #n ")" ::: "memory")
#define PG8_BAR __builtin_amdgcn_s_barrier()
#define PG8_SCHED __builtin_amdgcn_sched_barrier(0)
    Unit cur, nxt; int ui = 0;
    if (!S.next(0, cur)) return;
    f32x4 acc[2][2][4][2];
#pragma unroll
    for (int a = 0; a < 2; ++a)
#pragma unroll
        for (int b = 0; b < 2; ++b)
#pragma unroll
            for (int m = 0; m < 4; ++m)
#pragma unroll
                for (int n = 0; n < 2; ++n) acc[a][b][m][n] = (f32x4){0.f, 0.f, 0.f, 0.f};
    bf16x8 At[4][2], B0[2][2], B1[2][2];
    const char* cA = (const char*)g.A + (size_t)cur.pm * tstepA + (cur.aoff + cur.k0) * 2; const char* cB = (const char*)g.Bt + (size_t)cur.pn * tstepB + (size_t)cur.k0 * 2;
    S.a_ready(cur);
    if constexpr (SP2) {
        PG8_STAGE(PG8_SB(0, 0), cB, voffB); PG8_STAGE(PG8_SB(0, 1), cB + hstepB, voffB); PG8_STAGE(PG8_SA(0, 0), cA, voffA); PG8_STAGE(PG8_SA(0, 1), cA + hstepA, voffA);
        if (wr == 1) PG8_BAR;
        PG8_WAIT_V(2); PG8_BAR;
        PG8_STAGE(PG8_SB(1, 0), cB + kstep, voffB); PG8_STAGE(PG8_SA(1, 0), cA + kstep, voffA); PG8_STAGE(PG8_SB(1, 1), cB + hstepB + kstep, voffB);
        PG8_WAIT_V(6); PG8_BAR;
    } else {
        PG8_STAGE(PG8_SB(0, 0), cB, voffB); PG8_STAGE(PG8_SA(0, 0), cA, voffA); PG8_STAGE(PG8_SB(0, 1), cB + hstepB, voffB); PG8_STAGE(PG8_SA(0, 1), cA + hstepA, voffA);
        if (wr == 1) PG8_BAR;
        PG8_WAIT_V(4); PG8_BAR;
        PG8_STAGE(PG8_SB(1, 0), cB + kstep, voffB); PG8_STAGE(PG8_SA(1, 0), cA + kstep, voffA); PG8_STAGE(PG8_SB(1, 1), cB + hstepB + kstep, voffB);
        PG8_WAIT_V(6); PG8_BAR;
    }
    for (;;) {
        const bool has_next = S.next(ui + 1, nxt);
        const char* nA = has_next ? (const char*)g.A + (size_t)nxt.pm * tstepA + (nxt.aoff + nxt.k0) * 2 : cA; const char* nB = has_next ? (const char*)g.Bt + (size_t)nxt.pn * tstepB + (size_t)nxt.k0 * 2 : cB;
        const int nt = cur.nt;
        for (int t = 0; t < nt; t += 2) {
            const bool last = (t == nt - 2);
            const char* a1 = cA + (size_t)(t + 1) * kstep;
            const char* a2 = last ? nA : cA + (size_t)(t + 2) * kstep; const char* b2 = last ? nB : cB + (size_t)(t + 2) * kstep;
            const char* a3 = a2 + kstep; const char* b3 = b2 + kstep;
            if (last && has_next) S.a_ready(nxt);
            if constexpr (SP2) {
            PG8_LDB(B0, 0, 0); PG8_LDB(B1, 0, 1); PG8_SCHED; PG8_LDA(At, 0, 0); PG8_STAGE(PG8_SA(1, 1), a1 + hstepA, voffA);
            PG8_WAIT_V(8); PG8_WAIT_L(0); PG8_BAR; PG8_MMA(0, 0, At, B0); PG8_MMA(0, 1, At, B1); PG8_BAR; PG8_SCHED;
            PG8_LDA(At, 0, 1); PG8_STAGE(PG8_SB(0, 0), b2, voffB); PG8_STAGE(PG8_SB(0, 1), b2 + hstepB, voffB); PG8_STAGE(PG8_SA(0, 0), a2, voffA);
            PG8_WAIT_V(8); PG8_WAIT_L(0); PG8_BAR; PG8_MMA(1, 0, At, B0); PG8_MMA(1, 1, At, B1); PG8_BAR; PG8_SCHED;
            PG8_LDB(B0, 1, 0); PG8_LDB(B1, 1, 1); PG8_SCHED; PG8_LDA(At, 1, 0); PG8_STAGE(PG8_SA(0, 1), a2 + hstepA, voffA);
            PG8_WAIT_V(8); PG8_WAIT_L(0); PG8_BAR; PG8_MMA(0, 0, At, B0); PG8_MMA(0, 1, At, B1); PG8_BAR; PG8_SCHED;
            PG8_LDA(At, 1, 1); PG8_STAGE(PG8_SB(1, 0), b3, voffB); PG8_STAGE(PG8_SB(1, 1), b3 + hstepB, voffB); PG8_STAGE(PG8_SA(1, 0), a3, voffA);
            PG8_WAIT_V(8); PG8_WAIT_L(0); PG8_BAR; PG8_MMA(1, 0, At, B0); PG8_MMA(1, 1, At, B1); PG8_BAR; PG8_SCHED;
            } else {
            PG8_LDB(B0, 0, 0); PG8_SCHED; PG8_LDA(At, 0, 0); PG8_STAGE(PG8_SA(1, 1), a1 + hstepA, voffA);
            PG8_WAIT_L(8); PG8_BAR; PG8_WAIT_L(0); PG8_MMA(0, 0, At, B0); PG8_BAR; PG8_SCHED;
            PG8_LDB(B1, 0, 1); PG8_STAGE(PG8_SB(0, 0), b2, voffB);
            PG8_BAR; PG8_WAIT_L(0); PG8_MMA(0, 1, At, B1); PG8_BAR;
            PG8_LDA(At, 0, 1); PG8_STAGE(PG8_SA(0, 0), a2, voffA);
            PG8_BAR; PG8_WAIT_L(0); PG8_MMA(1, 0, At, B0); PG8_BAR; PG8_SCHED;
            PG8_STAGE(PG8_SB(0, 1), b2 + hstepB, voffB);
            PG8_WAIT_V(6); PG8_BAR; PG8_MMA(1, 1, At, B1); PG8_BAR;
            PG8_LDB(B0, 1, 0); PG8_SCHED; PG8_LDA(At, 1, 0); PG8_STAGE(PG8_SA(0, 1), a2 + hstepA, voffA);
            PG8_WAIT_L(8); PG8_BAR; PG8_WAIT_L(0); PG8_MMA(0, 0, At, B0); PG8_BAR; PG8_SCHED;
            PG8_LDB(B1, 1, 1); PG8_STAGE(PG8_SB(1, 0), b3, voffB);
            PG8_BAR; PG8_WAIT_L(0); PG8_MMA(0, 1, At, B1); PG8_BAR;
            PG8_LDA(At, 1, 1); PG8_STAGE(PG8_SA(1, 0), a3, voffA);
            PG8_BAR; PG8_WAIT_L(0); PG8_MMA(1, 0, At, B0); PG8_BAR; PG8_SCHED;
            PG8_STAGE(PG8_SB(1, 1), b3 + hstepB, voffB);
            PG8_WAIT_V(6); PG8_BAR; PG8_MMA(1, 1, At, B1); PG8_BAR;
            }
        }
        if constexpr (ALIGN_EPI) { if (wr == 0) PG8_BAR; }
        if constexpr (!Epi::AFTER_DRAIN) { E(acc, cur, wr, wc, fr, fq); S.done(cur); }
        if (!has_next) break;
#pragma unroll
        for (int a = 0; a < 2; ++a)
#pragma unroll
            for (int b = 0; b < 2; ++b)
#pragma unroll
                for (int m = 0; m < 4; ++m)
#pragma unroll
                    for (int n = 0; n < 2; ++n) acc[a][b][m][n] = (f32x4){0.f, 0.f, 0.f, 0.f};
        cur = nxt; cA = nA; cB = nB; ++ui;
        if constexpr (ALIGN_EPI) { if (wr == 1) PG8_BAR; }
    }
    PG8_WAIT_V(0);
    if constexpr (!ALIGN_EPI) { if (wr == 0) PG8_BAR; }
    PG8_BAR;
    if constexpr (Epi::AFTER_DRAIN) { E.fused(acc, cur, wr, wc, fr, fq, lds, wid, lane); S.done(cur); }
#undef PG8_SA
#undef PG8_SB
#undef PG8_STAGE
#undef PG8_LDA
#undef PG8_LDB
#undef PG8_MMA
#undef PG8_WAIT_V
#undef PG8_WAIT_L
#undef PG8_BAR
#undef PG8_SCHED
}
}

using pg8::bf16_t; using pg8::bf16x8; using pg8::f32x4; using pg8::u32x4; using pg8::u32x2; using pg8::cvt_pk_bf16; using pg8::fsigmoid;
#define LAS __attribute__((address_space(3)))
typedef float f32x16 __attribute__((ext_vector_type(16)));
typedef short s16x4 __attribute__((ext_vector_type(4)));
constexpr int D = 1024, NLAT = 16384, NCTX = 1024, MT = NLAT + NCTX, SEQ = 4096, CTXL = 256, DFF = 2816;
constexpr size_t MiB = 1u << 20;
constexpr size_t WS_MOD = 0, WS_H = 1 * MiB, WS_A = 69 * MiB, WS_B = 137 * MiB, WS_C = 239 * MiB, WS_ATTW = 345 * MiB, WS_S = 375 * MiB, WS_END = 384 * MiB;
constexpr size_t ACT = (size_t)MT * D;
constexpr int LDS_BYTES = 147456;
constexpr int NPH = 35;
enum { I_X = 0, I_C, I_CTX, I_CCTX, I_MODW, I_MODB, I_NMIX, I_NFFN, I_FW1, I_FW3, I_FW2, I_MU, I_WR, I_WK, I_WV, I_WO, I_W0, I_W1, I_W2, I_A0, I_A1, I_A2,
       I_G1, I_G2, I_KK, I_KA, I_RK, I_LNG, I_LNB, I_AWQ, I_AWK, I_AWV, I_AWO, I_AGQ, I_AGK, I_NWQKV, I_NWO, I_NGQ, I_NGK, I_RPB };
struct Params { const float* in[40]; float* out; unsigned char* ws; int ph_lo, ph_hi; };
#define CAS __attribute__((address_space(4)))
struct PV { int z; };
__device__ __forceinline__ const float* pin(int i, int z) { const CAS char* ka = (const CAS char*)__builtin_amdgcn_kernarg_segment_ptr(); return *(const float* const CAS*)(ka + 8 * i + z); }
#define PIN(i) pin((i), p.z)

__device__ __forceinline__ int opq(int x) { asm volatile("" : "+v"(x)); return x; }
__device__ __forceinline__ float bf2f(unsigned x) { return __uint_as_float(x << 16); }
__device__ __forceinline__ void unpack8(const u32x4 w, float* f) {
    f[0] = __uint_as_float(w.x << 16); f[1] = __uint_as_float(w.x & 0xffff0000u); f[2] = __uint_as_float(w.y << 16); f[3] = __uint_as_float(w.y & 0xffff0000u);
    f[4] = __uint_as_float(w.z << 16); f[5] = __uint_as_float(w.z & 0xffff0000u); f[6] = __uint_as_float(w.w << 16); f[7] = __uint_as_float(w.w & 0xffff0000u);
}
__device__ __forceinline__ f32x4 unpack4(const u32x2 w) {
    f32x4 r; r[0] = __uint_as_float(w.x << 16); r[1] = __uint_as_float(w.x & 0xffff0000u); r[2] = __uint_as_float(w.y << 16); r[3] = __uint_as_float(w.y & 0xffff0000u); return r;
}
__device__ __forceinline__ u32x4 pack8(const float* f) { u32x4 w; w.x = cvt_pk_bf16(f[0], f[1]); w.y = cvt_pk_bf16(f[2], f[3]); w.z = cvt_pk_bf16(f[4], f[5]); w.w = cvt_pk_bf16(f[6], f[7]); return w; }
template <int CTRL> __device__ __forceinline__ float dpp_add(float x) {
    return x + __builtin_bit_cast(float, __builtin_amdgcn_update_dpp(0, __builtin_bit_cast(int, x), CTRL, 0xF, 0xF, true));
}
__device__ __forceinline__ float red4(float x) { x = dpp_add<0xB1>(x); x = dpp_add<0x4E>(x); return x; }
__device__ __forceinline__ float red8(float x) { x = red4(x); x = dpp_add<0x141>(x); return x; }
__device__ __forceinline__ float red16(float x) { x = red8(x); x = dpp_add<0x140>(x); return x; }
__device__ __forceinline__ float wave_sum(float v) { v = red16(v); v += __shfl_xor(v, 16); v += __shfl_xor(v, 32); return v; }

struct CvtJob { const float* src; const float* scale; bf16_t* dst; int K, N, ld, col_off, row_off, mode; };
__device__ __forceinline__ void cvt_run(const CvtJob& J, int& gw, int ngw, int lane) {
    if (J.K <= 0) return;
    const int nb = J.N >> 6, nitems = (J.K >> 4) * nb;
    const int g0 = gw; { int r = (gw - nitems) % ngw; if (r < 0) r += ngw; gw = r; }
    for (int it = g0; it < nitems; it += ngw) {
        const int k0 = (it / nb) << 4, n = ((it % nb) << 6) + lane;
        float v[16];
#pragma unroll
        for (int i = 0; i < 16; ++i) { float x = 0.f; if (J.src) { x = J.src[(size_t)(k0 + i) * J.N + n]; if (J.scale) x *= J.scale[k0 + i]; } v[i] = x; }
        int dr = n; if (J.mode == 1) dr = ((n >> 2) << 3) + (n & 3); else if (J.mode == 2) dr = ((n >> 2) << 3) + 4 + (n & 3);
        bf16_t* dp = J.dst + (size_t)(J.row_off + dr) * J.ld + J.col_off + k0;
        *(u32x4*)dp = pack8(v); *(u32x4*)(dp + 8) = pack8(v + 8);
    }
}
__device__ __forceinline__ CvtJob mkjob(const float* src, const float* scale, bf16_t* dst, int K, int N, int ld, int col_off, int row_off, int mode) {
    CvtJob J; J.src = src; J.scale = scale; J.dst = dst; J.K = K; J.N = N; J.ld = ld; J.col_off = col_off; J.row_off = row_off; J.mode = mode; return J;
}
__device__ __forceinline__ void cvt_rwkv_mixer(const PV p, int j, bf16_t* W1b, bf16_t* W2b, bf16_t* Wo, int gw, int ngw, int lane) {
    const size_t DD = (size_t)D * D;
    cvt_run(mkjob(PIN(I_WR) + j * DD, nullptr, W1b, D, D, 1024, 0, 0, 0), gw, ngw, lane);
    cvt_run(mkjob(PIN(I_WK) + j * DD, nullptr, W1b, D, D, 1024, 0, 1024, 0), gw, ngw, lane);
    cvt_run(mkjob(PIN(I_WV) + j * DD, nullptr, W1b, D, D, 1024, 0, 2048, 0), gw, ngw, lane);
    for (int e = 0; e < 2; ++e) {
        cvt_run(mkjob(PIN(I_W1) + ((size_t)j * 2 + e) * D * 64, nullptr, W1b, D, 64, 1024, 0, 3072 + 64 * e, 0), gw, ngw, lane);
        cvt_run(mkjob(PIN(I_A1) + ((size_t)j * 2 + e) * D * 64, nullptr, W1b, D, 64, 1024, 0, 3328 + 64 * e, 0), gw, ngw, lane);
    }
    cvt_run(mkjob(PIN(I_G1) + (size_t)j * D * 128, nullptr, W1b, D, 128, 1024, 0, 3584, 0), gw, ngw, lane);
    cvt_run(mkjob(nullptr, nullptr, W1b, D, 128, 1024, 0, 3200, 0), gw, ngw, lane);
    cvt_run(mkjob(nullptr, nullptr, W1b, D, 128, 1024, 0, 3456, 0), gw, ngw, lane);
    cvt_run(mkjob(nullptr, nullptr, W1b, D, 128, 1024, 0, 3712, 0), gw, ngw, lane);
    for (int rg = 0; rg < 5; ++rg) {
        const int c0 = rg < 4 ? 64 * rg : 256, kw = rg < 4 ? 64 : 128;
        const float* src = rg == 0 ? PIN(I_W2) + ((size_t)j * 2 + 0) * 64 * D : rg == 1 ? PIN(I_W2) + ((size_t)j * 2 + 1) * 64 * D
                         : rg == 2 ? PIN(I_A2) + ((size_t)j * 2 + 0) * 64 * D : rg == 3 ? PIN(I_A2) + ((size_t)j * 2 + 1) * 64 * D : PIN(I_G2) + (size_t)j * 128 * D;
        cvt_run(mkjob(src, nullptr, W2b, kw, D, 384, c0, rg * 1024, 0), gw, ngw, lane);
        cvt_run(mkjob(nullptr, nullptr, W2b, c0, D, 384, 0, rg * 1024, 0), gw, ngw, lane);
        cvt_run(mkjob(nullptr, nullptr, W2b, 384 - c0 - kw, D, 384, c0 + kw, rg * 1024, 0), gw, ngw, lane);
    }
    cvt_run(mkjob(PIN(I_WO) + j * DD, nullptr, Wo, D, D, 1024, 0, 0, 0), gw, ngw, lane);
}
__device__ __forceinline__ void cvt_ffn(const PV p, int L, bf16_t* W13, bf16_t* W2t, int gw, int ngw, int lane) {
    const size_t FW = (size_t)D * DFF;
    cvt_run(mkjob(PIN(I_FW1) + L * FW, nullptr, W13, D, DFF, 1024, 0, 0, 1), gw, ngw, lane);
    cvt_run(mkjob(PIN(I_FW3) + L * FW, nullptr, W13, D, DFF, 1024, 0, 0, 2), gw, ngw, lane);
    cvt_run(mkjob(PIN(I_FW2) + L * FW, nullptr, W2t, DFF, D, DFF, 0, 0, 0), gw, ngw, lane);
}

__device__ __forceinline__ void phase_mod(const PV p, LAS float* sc  , float* MOD) {
    const int tid = opq((int)threadIdx.x);
    for (int i = tid; i < 5 * D; i += 512) { const float c = i < 4 * D ? PIN(I_C)[i] : PIN(I_CCTX)[i - 4 * D]; sc[i] = c / (1.0f + __expf(-c)); }
    __syncthreads();
    LAS float* red = sc + 5 * D;
    for (int it = blockIdx.x; it < 384; it += gridDim.x) {
        const int l = it / 96, e0 = (it % 96) * 64, el = tid & 63, dq = tid >> 6;
        const float* w = PIN(I_MODW) + ((size_t)l * D + dq * 128) * 6144 + e0 + el;
        float a0 = 0.f, a1 = 0.f, a2 = 0.f, a3 = 0.f, a4 = 0.f;
#pragma unroll 16
        for (int d = 0; d < 128; ++d) { const float x = w[(size_t)d * 6144]; const int dd = dq * 128 + d;
            a0 += sc[dd] * x; a1 += sc[D + dd] * x; a2 += sc[2 * D + dd] * x; a3 += sc[3 * D + dd] * x; a4 += sc[4 * D + dd] * x; }
        LAS float* rp = red + (dq * 64 + el) * 5; rp[0] = a0; rp[1] = a1; rp[2] = a2; rp[3] = a3; rp[4] = a4;
        __syncthreads();
        if (tid < 320) { const int e = tid & 63, jj = tid >> 6; float s = 0.f;
#pragma unroll
            for (int q = 0; q < 8; ++q) s += red[(q * 64 + e) * 5 + jj];
            MOD[((size_t)l * 5 + jj) * 6144 + e0 + e] = s + PIN(I_MODB)[l * 6144 + e0 + e]; }
        __syncthreads();
    }
}

__device__ __forceinline__ void norm_row(const float* hrow, const float* g, const float* scv, const float* shv, int lane, f32x4 (&a)[4], const float* prow = nullptr, int nsplit = 0, float* wb = nullptr) {
    f32x4 v[4]; float ss = 0.f;
#pragma unroll
    for (int j = 0; j < 4; ++j) { v[j] = *(const f32x4*)(hrow + 4 * lane + 256 * j);
        if (nsplit) { f32x4 pp[11];
#pragma unroll
            for (int s_ = 0; s_ < 11; ++s_) pp[s_] = (s_ < nsplit) ? *(const f32x4*)(prow + (size_t)s_ * 1048576 + 4 * lane + 256 * j) : (f32x4){0.f, 0.f, 0.f, 0.f};
#pragma unroll
            for (int s_ = 0; s_ < 11; ++s_) v[j] += pp[s_];
            *(f32x4*)(wb + 4 * lane + 256 * j) = v[j]; } ss += (v[j][0] * v[j][0] + v[j][1] * v[j][1]) + (v[j][2] * v[j][2] + v[j][3] * v[j][3]); }
    const float rstd = rsqrtf(wave_sum(ss) * (1.0f / D) + 1e-6f);
#pragma unroll
    for (int j = 0; j < 4; ++j) { const int c = 4 * lane + 256 * j; const f32x4 gg = *(const f32x4*)(g + c), s1 = *(const f32x4*)(scv + c), s0 = *(const f32x4*)(shv + c);
        a[j] = v[j] * rstd * gg * (1.0f + s1) + s0; }
}
__device__ __forceinline__ void phase_norm(const float* base_lat, const float* base_ctx, const float* g, const float* modl  , int off_sh, int off_sc,
                                           bf16_t* out, int M, int gw, int ngw, int lane, float* Hw = nullptr, const float* part = nullptr, int nsplit = 0) {
    for (int row = gw; row < NLAT; row += 2 * ngw) {
        const int row2 = row + ngw; const bool has2 = row2 < NLAT; const int r2 = has2 ? row2 : row;
        const float* mv = modl + (row >> 12) * 6144; const float* mv2 = modl + (r2 >> 12) * 6144;
        const float* h1 = base_lat + (size_t)row * D; const float* h2 = base_lat + (size_t)r2 * D;
        f32x4 v1[4], v2[4]; float s1 = 0.f, s2 = 0.f;
#pragma unroll
        for (int j = 0; j < 4; ++j) { v1[j] = *(const f32x4*)(h1 + 4 * lane + 256 * j); v2[j] = *(const f32x4*)(h2 + 4 * lane + 256 * j); }
#pragma unroll
        for (int j = 0; j < 4; ++j) { s1 += (v1[j][0] * v1[j][0] + v1[j][1] * v1[j][1]) + (v1[j][2] * v1[j][2] + v1[j][3] * v1[j][3]); s2 += (v2[j][0] * v2[j][0] + v2[j][1] * v2[j][1]) + (v2[j][2] * v2[j][2] + v2[j][3] * v2[j][3]); }
        const float rs1 = rsqrtf(wave_sum(s1) * (1.0f / D) + 1e-6f), rs2 = rsqrtf(wave_sum(s2) * (1.0f / D) + 1e-6f);
#pragma unroll
        for (int j = 0; j < 4; ++j) { const int c = 4 * lane + 256 * j; const f32x4 gg = *(const f32x4*)(g + c);
            { const f32x4 sc = *(const f32x4*)(mv + off_sc + c), sh = *(const f32x4*)(mv + off_sh + c); const f32x4 a = v1[j] * rs1 * gg * (1.0f + sc) + sh;
              u32x2 w; w.x = cvt_pk_bf16(a[0], a[1]); w.y = cvt_pk_bf16(a[2], a[3]); *(u32x2*)(out + (size_t)row * D + c) = w; }
            if (has2) { const f32x4 sc = *(const f32x4*)(mv2 + off_sc + c), sh = *(const f32x4*)(mv2 + off_sh + c); const f32x4 a = v2[j] * rs2 * gg * (1.0f + sc) + sh;
              u32x2 w; w.x = cvt_pk_bf16(a[0], a[1]); w.y = cvt_pk_bf16(a[2], a[3]); *(u32x2*)(out + (size_t)row2 * D + c) = w; } }
    }
    for (int row = NLAT + gw; row < M; row += ngw) {
        const float* mv = modl + 4 * 6144;
        f32x4 a[4];
        if (nsplit) norm_row(base_ctx + (size_t)row * D, g, mv + off_sc, mv + off_sh, lane, a, part + (size_t)(row - NLAT) * D, nsplit, Hw + (size_t)row * D);
        else norm_row(base_ctx + (size_t)row * D, g, mv + off_sc, mv + off_sh, lane, a);
#pragma unroll
        for (int j = 0; j < 4; ++j) { u32x2 w; w.x = cvt_pk_bf16(a[j][0], a[j][1]); w.y = cvt_pk_bf16(a[j][2], a[j][3]); *(u32x2*)(out + (size_t)row * D + 4 * lane + 256 * j) = w; }
    }
}
__device__ __forceinline__ void load_row4(const float* __restrict__ hrow, int lane, f32x4 (&v)[4]) {
#pragma unroll
    for (int j = 0; j < 4; ++j) v[j] = *(const f32x4*)(hrow + 4 * lane + 256 * j);
}
__device__ __forceinline__ void norm_finish(f32x4 (&v)[4], const float* __restrict__ g, const float* __restrict__ scv, const float* __restrict__ shv, int lane) {
    float ss = 0.f;
#pragma unroll
    for (int j = 0; j < 4; ++j) ss += (v[j][0] * v[j][0] + v[j][1] * v[j][1]) + (v[j][2] * v[j][2] + v[j][3] * v[j][3]);
    const float rstd = rsqrtf(wave_sum(ss) * (1.0f / D) + 1e-6f);
#pragma unroll
    for (int j = 0; j < 4; ++j) { const int c = 4 * lane + 256 * j; const f32x4 gg = *(const f32x4*)(g + c), s1 = *(const f32x4*)(scv + c), s0 = *(const f32x4*)(shv + c);
        v[j] = v[j] * rstd * gg * (1.0f + s1) + s0; }
}
__device__ __forceinline__ void phase_norm_shift(const float* __restrict__ base_lat, const float* __restrict__ base_ctx, const float* __restrict__ g, const float* __restrict__ modl, const float* __restrict__ mu,
                                                 bf16_t* __restrict__ XA, bf16_t* __restrict__ XC, int gw, int ngw, int lane) {
    for (int pi = gw; pi < MT / 2; pi += ngw) {
        const int row = 2 * pi; const bool lat = row < NLAT; const int bidx = lat ? row >> 12 : 4; const float* hb = lat ? base_lat : base_ctx; const float* mv = modl + bidx * 6144;
        const int t = lat ? (row & 4095) : ((row - NLAT) & 255), len = lat ? SEQ : CTXL; const bool hasp = t > 0, hasn = t + 2 < len;
        f32x4 a0[4], a1[4], ap[4], an[4];
        load_row4(hb + (size_t)row * D, lane, a0); load_row4(hb + (size_t)(row + 1) * D, lane, a1);
        load_row4(hb + (size_t)(hasp ? row - 1 : row) * D, lane, ap); load_row4(hb + (size_t)(hasn ? row + 2 : row) * D, lane, an);
        norm_finish(a0, g, mv + 1024, mv, lane); norm_finish(a1, g, mv + 1024, mv, lane); norm_finish(ap, g, mv + 1024, mv, lane); norm_finish(an, g, mv + 1024, mv, lane);
        const float fp = hasp ? 0.5f : 0.f, fn = hasn ? 0.5f : 0.f;
#pragma unroll
        for (int j = 0; j < 4; ++j) { const f32x4 xx0 = fp * ap[j] + 0.5f * a1[j] - a0[j], xx1 = 0.5f * a0[j] + fn * an[j] - a1[j]; const int c = 4 * lane + 256 * j; const size_t e0 = (size_t)row * D + c;
#pragma unroll
            for (int i = 0; i < 6; ++i) {
                const f32x4 m_ = *(const f32x4*)(mu + i * D + c); const f32x4 x0 = a0[j] + xx0 * m_, x1 = a1[j] + xx1 * m_;
                bf16_t* dst = (i == 0) ? XC : (i == 1) ? XC + 3 * ACT : (i == 2) ? XC + ACT : (i == 3) ? XC + 2 * ACT : (i == 4) ? XA : XA + ACT;
                u32x2 w0; w0.x = cvt_pk_bf16(x0[0], x0[1]); w0.y = cvt_pk_bf16(x0[2], x0[3]); *(u32x2*)(dst + e0) = w0;
                u32x2 w1; w1.x = cvt_pk_bf16(x1[0], x1[1]); w1.y = cvt_pk_bf16(x1[2], x1[3]); *(u32x2*)(dst + e0 + D) = w1; } }
    }
}

__device__ __forceinline__ int scan_row(int ci, int tt, int dir, int b) {
    if (ci < 8) { const int s = ci * 32 + tt; return NLAT + b * CTXL + (dir ? CTXL - 1 - s : s); }
    const int s = (ci - 8) * 32 + tt; return b * SEQ + (dir ? SEQ - 1 - s : s);
}
#ifndef SCAN_PROBE
#define SCAN_PROBE 0
#endif
typedef float f32x2 __attribute__((ext_vector_type(2)));
struct ScanRaw { u32x2 r, k, v, lw, la; };
__device__ __forceinline__ ScanRaw scan_load(const bf16_t* R, const bf16_t* LWd, size_t e) {
    ScanRaw x; x.r = *(const u32x2*)(R + e); x.k = *(const u32x2*)(R + ACT + e); x.v = *(const u32x2*)(R + 2 * ACT + e); x.lw = *(const u32x2*)(LWd + e); x.la = *(const u32x2*)(LWd + 2 * ACT + e); return x;
}
__device__ __forceinline__ int scan_row16(int ci, int t, int dir, int b) {
    if (ci < 16) { const int s = ci * 16 + t; return NLAT + b * CTXL + (dir ? CTXL - 1 - s : s); }
    const int s = (ci - 16) * 16 + t; return b * SEQ + (dir ? SEQ - 1 - s : s);
}
__device__ __forceinline__ bf16x8 ldfrag(const LAS unsigned char* base, int stride, int row, int kbyte) { return *(const LAS bf16x8*)(base + row * stride + kbyte); }
__device__ __forceinline__ unsigned short f2bf1(float x) { unsigned u = __float_as_uint(x); u += 0x7fffu + ((u >> 16) & 1u); return (unsigned short)(u >> 16); }
#define MFMA16(a, b, c) __builtin_amdgcn_mfma_f32_16x16x32_bf16((a), (b), (c), 0, 0, 0)
__device__ __forceinline__ void phase_scan(const PV p, int j, LAS unsigned char* lds, const bf16_t* R, const bf16_t* K, const bf16_t* V, const bf16_t* LW, const bf16_t* LA,
                                           bf16_t* Y, float* COEF) {
    const int tid = opq((int)threadIdx.x), lane = tid & 63, w = __builtin_amdgcn_readfirstlane(tid >> 6), l15 = lane & 15, quad = lane >> 4;
    constexpr int SA = 144, SB = 80;
    constexpr int O_AB = 0, O_RB = 2304, O_VT = 4608, O_BTT = 9728, O_KTT = 14848, O_PC = 19968, RINGSZ = 20224;
    constexpr int O_NQ = 4 * RINGSZ, O_NKAT = 0, O_QBRT = 1280, O_QKRT = 2560, O_TT = 3840, NQSZ = 5120;
    constexpr int O_BK = O_NQ + 2 * NQSZ, O_BB = 0, O_KB = 2304, BKSZ = 4608;
    constexpr int O_LW = O_BK + 2 * BKSZ, O_NBA = O_LW + 4096, O_PRIV = O_NBA + 1024, PRIVSZ = 4864, O_YB = O_PRIV + 4 * PRIVSZ, O_TS = O_YB + 2 * 2048, O_END = O_TS + 3840;
    constexpr int NCH = 272;
#define SC_BAR() do { asm volatile("s_waitcnt lgkmcnt(0)" ::: "memory"); __builtin_amdgcn_s_barrier(); asm volatile("" ::: "memory"); } while (0)
    for (int u = blockIdx.x; u < 256; u += gridDim.x) {
        const int half = u & 1, dir = (u >> 1) & 1, h = (u >> 2) & 15, b = u >> 6;
        __syncthreads();
        for (int i = tid; i < O_END / 16; i += 512) ((LAS u32x4*)lds)[i] = (u32x4){0u, 0u, 0u, 0u};
        __syncthreads();
        bf16_t* Yd = Y + (size_t)dir * ACT;
        if (w == 2 || w == 3 || w == 6 || w == 7) {
            const int hw = (w & 1) | ((w >> 2) << 1), t = hw * 4 + (lane >> 4), nq = lane & 15, ncol = h * 64 + 4 * nq;
            const f32x4 kkc = *(const f32x4*)(PIN(I_KK) + j * D + ncol), kac = *(const f32x4*)(PIN(I_KA) + j * D + ncol), rkc = *(const f32x4*)(PIN(I_RK) + j * D + ncol);
            const f32x4 w0c = *(const f32x4*)(PIN(I_W0) + (j * 2 + dir) * D + ncol), a0c = *(const f32x4*)(PIN(I_A0) + (j * 2 + dir) * D + ncol);
            const bf16_t* LWd = LW + (size_t)dir * ACT; float* Cd = COEF + (size_t)dir * MT * 16;
            ScanRaw ra = scan_load(R, LWd, (size_t)scan_row16(0, t, dir, b) * D + ncol);
            f32x4 al4, be4, kd4, r4, lw4, cw4, iw4;
            const float fh0 = hw > 0 ? 1.f : 0.f, fh1 = hw > 1 ? 1.f : 0.f, fh2 = hw > 2 ? 1.f : 0.f, m16_ = lane >= 16 ? 1.f : 0.f, m32_ = lane >= 32 ? 1.f : 0.f;
            for (int c = -3; c <= NCH; ++c) {
                const int n = c + 2, n0 = c + 3; const bool act1 = n >= 0 && n < NCH, act0 = n0 < NCH;
                LAS unsigned char* rg = lds + ((n + 4) & 3) * RINGSZ; LAS unsigned char* bk = lds + O_BK + (n & 1) * BKSZ; LAS unsigned char* rg0 = lds + (n0 & 3) * RINGSZ;
                LAS unsigned char* wt1 = lds + O_LW + (n & 1) * 1024; LAS unsigned char* wt0w = lds + O_LW + (n0 & 1) * 1024;
                if (act1) {
#if SCAN_PROBE == 3
                    for (int rep_ = 0; rep_ < 2; ++rep_) { asm volatile("" ::: "memory");
#endif
                    const f32x4 wt0 = *(const LAS f32x4*)(wt1 + (0 * 64 + 4 * nq) * 4), wt1v = *(const LAS f32x4*)(wt1 + (1 * 64 + 4 * nq) * 4),
                                wt2 = *(const LAS f32x4*)(wt1 + (2 * 64 + 4 * nq) * 4), wt3 = *(const LAS f32x4*)(wt1 + (3 * 64 + 4 * nq) * 4);
                    const f32x4 z4_ = {0.f, 0.f, 0.f, 0.f};
                    const f32x4 cum = ((cw4 + wt0 * fh0) + wt1v * fh1) + wt2 * fh2, tot = (wt0 + wt1v) + (wt2 + wt3);
                    f32x4 ab, bb, kb, rb, bt, kt, pc;
#pragma unroll
                    for (int i = 0; i < 4; ++i) { const float pt = __builtin_amdgcn_exp2f(cum[i]), ip = __builtin_amdgcn_rcpf(pt), pp = pt * iw4[i], cp = __builtin_amdgcn_exp2f(tot[i] - cum[i]); pc[i] = pt;
                        ab[i] = al4[i] * pp; bb[i] = be4[i] * ip; kb[i] = kd4[i] * ip; rb[i] = r4[i] * pt; bt[i] = be4[i] * cp; kt[i] = kd4[i] * cp; }
                    u32x2 q; q.x = cvt_pk_bf16(ab[0], ab[1]); q.y = cvt_pk_bf16(ab[2], ab[3]); *(LAS u32x2*)(rg + O_AB + t * SA + nq * 8) = q;
                    q.x = cvt_pk_bf16(rb[0], rb[1]); q.y = cvt_pk_bf16(rb[2], rb[3]); *(LAS u32x2*)(rg + O_RB + t * SA + nq * 8) = q;
                    q.x = cvt_pk_bf16(bb[0], bb[1]); q.y = cvt_pk_bf16(bb[2], bb[3]); *(LAS u32x2*)(bk + O_BB + t * SA + nq * 8) = q;
                    q.x = cvt_pk_bf16(kb[0], kb[1]); q.y = cvt_pk_bf16(kb[2], kb[3]); *(LAS u32x2*)(bk + O_KB + t * SA + nq * 8) = q;
#pragma unroll
                    for (int i = 0; i < 4; ++i) { *(LAS unsigned short*)(rg + O_BTT + (i * 16 + nq) * SB + t * 2) = f2bf1(bt[i]); *(LAS unsigned short*)(rg + O_KTT + (i * 16 + nq) * SB + t * 2) = f2bf1(kt[i]); }
                    if (t == 15) *(LAS f32x4*)(rg + O_PC + 16 * nq) = pc;
#if SCAN_PROBE == 3
                    }
#endif
                }
                if (act0) {
#if SCAN_PROBE == 2
                    for (int rep_ = 0; rep_ < 2; ++rep_) { asm volatile("" ::: "memory");
#endif
                    r4 = unpack4(ra.r); const f32x4 k4 = unpack4(ra.k), lwl = unpack4(ra.lw), la4 = unpack4(ra.la);
                    const f32x4 kkr = k4 * kkc; float ss_ = (kkr[0] * kkr[0] + kkr[1] * kkr[1]) + (kkr[2] * kkr[2] + kkr[3] * kkr[3]); ss_ = red16(ss_);
                    const float inv = __builtin_amdgcn_rcpf(fmaxf(__builtin_amdgcn_sqrtf(ss_), 1e-12f)); const f32x4 kk4 = kkr * inv; f32x4 a4;
#pragma unroll
                    for (int i = 0; i < 4; ++i) { lw4[i] = (-0.6065306597126334f * 1.4426950408889634f) * fsigmoid(w0c[i] + lwl[i]); iw4[i] = __builtin_amdgcn_exp2f(-lw4[i]); a4[i] = fsigmoid(a0c[i] + la4[i]); }
                    kd4 = k4 * (1.0f + (a4 - 1.0f) * kac); be4 = kk4 * a4; al4 = -kk4;
                    if (half == 0) { const f32x4 rq = r4 * kd4 * rkc; float cf = (rq[0] + rq[1]) + (rq[2] + rq[3]); cf = red16(cf);
                        if (nq == 0) Cd[(size_t)scan_row16(n0, t, dir, b) * 16 + h] = cf; }
                    cw4 = lw4;
#pragma unroll
                    for (int i = 0; i < 4; ++i) { float y_ = __shfl_up(cw4[i], 16); cw4[i] = fmaf(y_, m16_, cw4[i]); y_ = __shfl_up(cw4[i], 32); cw4[i] = fmaf(y_, m32_, cw4[i]); }
                    if (lane >= 48) *(LAS f32x4*)(wt0w + (hw * 64 + 4 * nq) * 4) = cw4;
                    {
                        *(LAS unsigned short*)(rg0 + O_VT + (0 * 16 + nq) * SB + t * 2) = (unsigned short)(ra.v.x & 0xffffu); *(LAS unsigned short*)(rg0 + O_VT + (1 * 16 + nq) * SB + t * 2) = (unsigned short)(ra.v.x >> 16);
                        *(LAS unsigned short*)(rg0 + O_VT + (2 * 16 + nq) * SB + t * 2) = (unsigned short)(ra.v.y & 0xffffu); *(LAS unsigned short*)(rg0 + O_VT + (3 * 16 + nq) * SB + t * 2) = (unsigned short)(ra.v.y >> 16); }
#if SCAN_PROBE == 2
                    }
#endif
                    if (n0 + 1 < NCH) ra = scan_load(R, LWd, (size_t)scan_row16(n0 + 1, t, dir, b) * D + ncol);
                }
                SC_BAR();
            }
        } else {
            const int cw = (w >= 4) ? (w - 4) : (w + 2), vrow0 = 32 * half + 16 * (cw & 1);
            LAS unsigned char* Sb = lds + O_PRIV + cw * PRIVSZ; LAS unsigned char* W2b = Sb + 2304; LAS unsigned char* Ub = W2b + 1280;
            f32x4 St0 = {0.f, 0.f, 0.f, 0.f}, St1 = St0, St2 = St0, St3 = St0;
            float one_ = 1.0f; asm volatile("" : "+v"(one_)); const f32x2 o2_ = {one_, one_};
#define SC_PK2(a_, b_) ({ const f32x2 t_ = (f32x2){(a_), (b_)} * o2_; cvt_pk_bf16(t_[0], t_[1]); })
#define SC_FENCE() asm volatile("s_waitcnt lgkmcnt(0)" ::: "memory")
            for (int c = -3; c <= NCH; ++c) {
                if (c >= 0 && c < NCH && cw < 2) {
                    const LAS unsigned char* rg = lds + (c & 3) * RINGSZ; const LAS unsigned char* nqb = lds + O_NQ + (c & 1) * NQSZ;
                    const int k0b = (8 * quad) * 2, k1b = (32 + 8 * quad) * 2, kq = 16 * quad;
                    const bf16x8 sb0 = ldfrag(Sb, SA, l15, k0b), sb1 = ldfrag(Sb, SA, l15, k1b);
                    const bf16x8 ab0 = ldfrag(rg + O_AB, SA, l15, k0b), ab1 = ldfrag(rg + O_AB, SA, l15, k1b), rb0 = ldfrag(rg + O_RB, SA, l15, k0b), rb1 = ldfrag(rg + O_RB, SA, l15, k1b);
                    const bf16x8 va = ldfrag(rg + O_VT, SB, ((vrow0 + l15) & 3) * 16 + ((vrow0 + l15) >> 2), kq);
                    const bf16x8 nka = ldfrag(nqb + O_NKAT, SB, l15, kq), ttf = ldfrag(nqb + O_TT, SB, l15, kq), qbr = ldfrag(nqb + O_QBRT, SB, l15, kq), qkr = ldfrag(nqb + O_QKRT, SB, l15, kq);
                    const bf16x8 bt0 = ldfrag(rg + O_BTT, SB, l15, kq), bt1 = ldfrag(rg + O_BTT, SB, 16 + l15, kq), bt2 = ldfrag(rg + O_BTT, SB, 32 + l15, kq), bt3 = ldfrag(rg + O_BTT, SB, 48 + l15, kq);
                    const bf16x8 kt0 = ldfrag(rg + O_KTT, SB, l15, kq), kt1 = ldfrag(rg + O_KTT, SB, 16 + l15, kq), kt2 = ldfrag(rg + O_KTT, SB, 32 + l15, kq), kt3 = ldfrag(rg + O_KTT, SB, 48 + l15, kq);
                    const f32x4 pcv = *(const LAS f32x4*)(rg + O_PC + 16 * l15); const float pc0 = pcv[0], pc1 = pcv[1], pc2 = pcv[2], pc3 = pcv[3];
                    SC_FENCE();
                    const f32x4 z4 = {0.f, 0.f, 0.f, 0.f};
                    f32x4 acc = MFMA16(sb0, ab0, z4); acc = MFMA16(sb1, ab1, acc); acc = MFMA16(va, nka, acc);
                    f32x4 accY = MFMA16(rb0, sb0, z4); accY = MFMA16(rb1, sb1, accY); accY = MFMA16(qkr, va, accY);
                    St0 = St0 * pc0; St1 = St1 * pc1; St2 = St2 * pc2; St3 = St3 * pc3;
                    St0 = MFMA16(va, kt0, St0); St1 = MFMA16(va, kt1, St1); St2 = MFMA16(va, kt2, St2); St3 = MFMA16(va, kt3, St3);
#pragma unroll
                    for (int jj = 0; jj < 4; jj += 2) { const unsigned pk_ = SC_PK2(acc[jj], acc[jj + 1]); *(LAS unsigned short*)(W2b + (quad * 4 + jj) * SB + l15 * 2) = (unsigned short)(pk_ & 0xffffu); *(LAS unsigned short*)(W2b + (quad * 4 + jj + 1) * SB + l15 * 2) = (unsigned short)(pk_ >> 16); }
                    SC_FENCE();
                    const bf16x8 w2f = ldfrag(W2b, SB, l15, kq);
                    SC_FENCE();
                    acc = MFMA16(w2f, ttf, z4);
#pragma unroll
                    for (int jj = 0; jj < 4; jj += 2) { const unsigned pk_ = SC_PK2(acc[jj], acc[jj + 1]); *(LAS unsigned short*)(Ub + (quad * 4 + jj) * SB + l15 * 2) = (unsigned short)(pk_ & 0xffffu); *(LAS unsigned short*)(Ub + (quad * 4 + jj + 1) * SB + l15 * 2) = (unsigned short)(pk_ >> 16); }
                    SC_FENCE();
                    const bf16x8 ua = ldfrag(Ub, SB, l15, kq);
                    SC_FENCE();
                    accY = MFMA16(qbr, ua, accY);
                    St0 = MFMA16(ua, bt0, St0); St1 = MFMA16(ua, bt1, St1); St2 = MFMA16(ua, bt2, St2); St3 = MFMA16(ua, bt3, St3);
#pragma unroll
                    for (int jj = 0; jj < 4; jj += 2) { const unsigned pk_ = SC_PK2(accY[jj], accY[jj + 1]); *(LAS unsigned short*)(lds + O_YB + (c & 1) * 2048 + (quad * 4 + jj) * 128 + (vrow0 + l15) * 2) = (unsigned short)(pk_ & 0xffffu); *(LAS unsigned short*)(lds + O_YB + (c & 1) * 2048 + (quad * 4 + jj + 1) * 128 + (vrow0 + l15) * 2) = (unsigned short)(pk_ >> 16); }
#pragma unroll
                    for (int jj = 0; jj < 4; ++jj) { u32x2 sq;
                        sq.x = SC_PK2(St0[jj], St1[jj]); sq.y = SC_PK2(St2[jj], St3[jj]);
                        *(LAS u32x2*)(Sb + (quad * 4 + jj) * SA + 8 * l15) = sq; }
                }
                if (cw == 3 && c >= 1) {
                    const int ts_ = lane >> 2, g8_ = lane & 3; const u32x4 yv = *(const LAS u32x4*)(lds + O_YB + ((c - 1) & 1) * 2048 + ts_ * 128 + half * 64 + g8_ * 16);
                    *(u32x4*)(Yd + (size_t)scan_row16(c - 1, ts_, dir, b) * D + h * 64 + half * 32 + g8_ * 8) = yv; }
                const int n = c + 1;
                if (n >= 0 && n < NCH) {
                    const int pidx = (cw == 0) ? 2 : (cw == 2) ? 0 : cw;
                    const LAS unsigned char* rg = lds + (n & 3) * RINGSZ; const LAS unsigned char* bk = lds + O_BK + (n & 1) * BKSZ; LAS unsigned char* nqb = lds + O_NQ + (n & 1) * NQSZ;
                    const LAS unsigned char* X = bk + ((pidx & 1) ? O_KB : O_BB); const LAS unsigned char* Yv = rg + ((pidx & 2) ? O_RB : O_AB);
                    f32x4 acc = {0.f, 0.f, 0.f, 0.f};
#pragma unroll
                    for (int ks = 0; ks < 2; ++ks) acc = MFMA16(ldfrag(X, SA, l15, (32 * ks + 8 * quad) * 2), ldfrag(Yv, SA, l15, (32 * ks + 8 * quad) * 2), acc);
                    const int ii = opq(l15);
                    f32x4 nm;
#pragma unroll
                    for (int jj = 0; jj < 4; ++jj) { const int mm = quad * 4 + jj; const bool keep = (pidx & 2) ? (mm <= ii) : (mm < ii); nm[jj] = keep ? acc[jj] : 0.f; }
                    if (pidx != 0) {
#pragma unroll
                        for (int jj = 0; jj < 4; jj += 2) *(LAS unsigned*)(nqb + (pidx == 1 ? O_NKAT : pidx == 2 ? O_QBRT : O_QKRT) + ii * SB + (quad * 4 + jj) * 2) = SC_PK2(nm[jj], nm[jj + 1]);
                    } else {
                        LAS unsigned char* TP = lds + O_TS; LAS unsigned char* TPT = TP + 1280; LAS unsigned char* TXT = TPT + 1280;
                        f32x4 Xs, Pc = nm;
#pragma unroll
                        for (int jj = 0; jj < 4; ++jj) Xs[jj] = nm[jj] + ((quad * 4 + jj) == ii ? 1.f : 0.f);
#pragma unroll
                        for (int lv = 0; lv < 4; ++lv) {
#pragma unroll
                            for (int jj = 0; jj < 4; jj += 2) { const int mm = quad * 4 + jj; const unsigned pp_ = SC_PK2(Pc[jj], Pc[jj + 1]);
                                *(LAS unsigned short*)(TP + mm * SB + ii * 2) = (unsigned short)(pp_ & 0xffffu); *(LAS unsigned short*)(TP + (mm + 1) * SB + ii * 2) = (unsigned short)(pp_ >> 16);
                                if (lv < 3) *(LAS unsigned*)(TPT + ii * SB + mm * 2) = pp_;
                                if (lv > 0) *(LAS unsigned*)(TXT + ii * SB + mm * 2) = SC_PK2(Xs[jj], Xs[jj + 1]); }
                            SC_FENCE();
                            const bf16x8 pa_ = ldfrag(TP, SB, l15, 16 * quad);
                            if (lv > 0) { const bf16x8 xb_ = ldfrag(TXT, SB, l15, 16 * quad); SC_FENCE(); Xs = MFMA16(pa_, xb_, Xs); }
                            if (lv < 3) { const bf16x8 pb_ = ldfrag(TPT, SB, l15, 16 * quad); SC_FENCE(); const f32x4 z4_ = {0.f, 0.f, 0.f, 0.f}; Pc = MFMA16(pa_, pb_, z4_); }
                            SC_FENCE();
                        }
#pragma unroll
                        for (int jj = 0; jj < 4; jj += 2) *(LAS unsigned*)(nqb + O_TT + ii * SB + (quad * 4 + jj) * 2) = SC_PK2(Xs[jj], Xs[jj + 1]);
                    }
                }
                SC_BAR();
            }
#undef SC_FENCE
#undef SC_PK2
        }
    }
}
#undef SC_BAR

struct RoRaw { u32x4 y0a, y0b, y1a, y1b, va, vb, ga, gb; float cf; };
__device__ __forceinline__ RoRaw ro_load(const bf16_t* Y, const bf16_t* V, const bf16_t* G, const float* COEF, int row, int lane) {
    const size_t e = (size_t)row * D + 16 * lane; RoRaw r;
    r.y0a = *(const u32x4*)(Y + e); r.y0b = *(const u32x4*)(Y + e + 8); r.y1a = *(const u32x4*)(Y + ACT + e); r.y1b = *(const u32x4*)(Y + ACT + e + 8);
    r.va = *(const u32x4*)(V + e); r.vb = *(const u32x4*)(V + e + 8); r.ga = *(const u32x4*)(G + e); r.gb = *(const u32x4*)(G + e + 8);
    r.cf = COEF[(size_t)row * 16 + (lane >> 2)] + COEF[(size_t)MT * 16 + (size_t)row * 16 + (lane >> 2)]; return r;
}
__device__ __forceinline__ void ro_finish(const RoRaw& r, const float* lg, const float* lb, bf16_t* Z, int row, int lane) {
    float y0[16], y1[16], v[16], g[16];
    unpack8(r.y0a, y0); unpack8(r.y0b, y0 + 8); unpack8(r.y1a, y1); unpack8(r.y1b, y1 + 8); unpack8(r.va, v); unpack8(r.vb, v + 8); unpack8(r.ga, g); unpack8(r.gb, g + 8);
    float s = 0.f;
#pragma unroll
    for (int i = 0; i < 16; ++i) { y0[i] += y1[i]; s += y0[i]; }
    const float mean = red4(s) * (1.0f / 64.0f); float qv = 0.f;
#pragma unroll
    for (int i = 0; i < 16; ++i) { y0[i] -= mean; qv += y0[i] * y0[i]; }
    const float rstd = rsqrtf(red4(qv) * (1.0f / 64.0f) + 64e-5f);
    float z[16];
#pragma unroll
    for (int i = 0; i < 16; ++i) z[i] = (y0[i] * rstd * lg[i] + lb[i] + r.cf * v[i]) * g[i];
    const size_t e = (size_t)row * D + 16 * lane;
    *(u32x4*)(Z + e) = pack8(z); *(u32x4*)(Z + e + 8) = pack8(z + 8);
}
__device__ __forceinline__ void phase_readout(const PV p, int j, const bf16_t* Y, const bf16_t* V, const bf16_t* G, const float* COEF, bf16_t* Z, int M, int gw, int ngw, int lane) {
    const float* lg = PIN(I_LNG) + j * D + 16 * lane; const float* lb = PIN(I_LNB) + j * D + 16 * lane;
    for (int row = gw; row < M; row += 2 * ngw) {
        const int row2 = row + ngw; const bool has2 = row2 < M;
        const RoRaw a = ro_load(Y, V, G, COEF, row, lane); const RoRaw b = ro_load(Y, V, G, COEF, has2 ? row2 : row, lane);
        ro_finish(a, lg, lb, Z, row, lane);
        if (has2) ro_finish(b, lg, lb, Z, row2, lane);
    }
}

__device__ __forceinline__ void gqa_head_c(float (&x)[16], const float* __restrict__ gvec, int lane8, bool rope, int gr, int gc) {
    float ss = 0.f;
#pragma unroll
    for (int i = 0; i < 16; ++i) ss += x[i] * x[i];
    const float rstd = rsqrtf(red8(ss) * (1.0f / 128.0f) + 1e-6f);
#pragma unroll
    for (int i = 0; i < 16; ++i) x[i] = x[i] * rstd * gvec[lane8 * 16 + i];
    if (rope) {
#pragma unroll
        for (int pi = 0; pi < 8; ++pi) { const int i = lane8 * 8 + pi; const int mm = i & 31; const float pos = (float)(i < 32 ? gr : gc);
            const float ang = pos * exp2f(-(float)mm * (13.287712379549449f / 32.0f)); const float c = __cosf(ang), s = __sinf(ang);
            const float x1 = x[2 * pi], x2 = x[2 * pi + 1]; x[2 * pi] = x1 * c - x2 * s; x[2 * pi + 1] = x1 * s + x2 * c; }
    }
}
__device__ __forceinline__ void phase_qknorm_gqa(const PV p, bf16_t* QKV, int gw, int ngw, int lane) {
    const float* gq = PIN(I_AGQ); const float* gk = PIN(I_AGK);
    for (int row = gw; row < MT; row += 2 * ngw) {
        const int row2 = row + ngw; const bool has2 = row2 < MT; const int r2 = has2 ? row2 : row;
        bf16_t* pa = QKV + (size_t)row * 1536 + 16 * lane; bf16_t* pb = QKV + (size_t)r2 * 1536 + 16 * lane; const bool kl = lane < 16;
        const u32x4 qa0 = *(const u32x4*)pa, qa1 = *(const u32x4*)(pa + 8), qb0 = *(const u32x4*)pb, qb1 = *(const u32x4*)(pb + 8);
        u32x4 ka0 = qa0, ka1 = qa1, kb0 = qb0, kb1 = qb1;
        if (kl) { ka0 = *(const u32x4*)(pa + 1024); ka1 = *(const u32x4*)(pa + 1032); kb0 = *(const u32x4*)(pb + 1024); kb1 = *(const u32x4*)(pb + 1032); }
        const bool latA = row < NLAT, latB = r2 < NLAT; const int tA = row & 4095, tB = r2 & 4095;
        float x[16];
        unpack8(qa0, x); unpack8(qa1, x + 8); gqa_head_c(x, gq, lane & 7, latA, tA >> 6, tA & 63); *(u32x4*)pa = pack8(x); *(u32x4*)(pa + 8) = pack8(x + 8);
        unpack8(qb0, x); unpack8(qb1, x + 8); gqa_head_c(x, gq, lane & 7, latB, tB >> 6, tB & 63); if (has2) { *(u32x4*)pb = pack8(x); *(u32x4*)(pb + 8) = pack8(x + 8); }
        if (kl) {
            unpack8(ka0, x); unpack8(ka1, x + 8); gqa_head_c(x, gk, lane & 7, latA, tA >> 6, tA & 63); *(u32x4*)(pa + 1024) = pack8(x); *(u32x4*)(pa + 1032) = pack8(x + 8);
            unpack8(kb0, x); unpack8(kb1, x + 8); gqa_head_c(x, gk, lane & 7, latB, tB >> 6, tB & 63); if (has2) { *(u32x4*)(pb + 1024) = pack8(x); *(u32x4*)(pb + 1032) = pack8(x + 8); }
        }
    }
}
__device__ __forceinline__ void na_head_c(float (&x)[16], const float* __restrict__ gvec, int lane4) {
    float ss = 0.f;
#pragma unroll
    for (int i = 0; i < 16; ++i) ss += x[i] * x[i];
    const float rstd = rsqrtf(red4(ss) * (1.0f / 64.0f) + 1e-6f);
#pragma unroll
    for (int i = 0; i < 16; ++i) x[i] = x[i] * rstd * gvec[lane4 * 16 + i];
}
__device__ __forceinline__ void phase_qknorm_na(const PV p, bf16_t* QKV, int gw, int ngw, int lane) {
    const float* gq = PIN(I_NGQ); const float* gk = PIN(I_NGK);
    for (int row = gw; row < MT; row += 2 * ngw) {
        const int row2 = row + ngw; const bool has2 = row2 < MT; const int r2 = has2 ? row2 : row;
        bf16_t* pa = QKV + (size_t)row * 3072 + 16 * lane; bf16_t* pb = QKV + (size_t)r2 * 3072 + 16 * lane;
        const u32x4 qa0 = *(const u32x4*)pa, qa1 = *(const u32x4*)(pa + 8), qb0 = *(const u32x4*)pb, qb1 = *(const u32x4*)(pb + 8);
        const u32x4 ka0 = *(const u32x4*)(pa + 1024), ka1 = *(const u32x4*)(pa + 1032), kb0 = *(const u32x4*)(pb + 1024), kb1 = *(const u32x4*)(pb + 1032);
        float x[16];
        unpack8(qa0, x); unpack8(qa1, x + 8); na_head_c(x, gq, lane & 3); *(u32x4*)pa = pack8(x); *(u32x4*)(pa + 8) = pack8(x + 8);
        unpack8(ka0, x); unpack8(ka1, x + 8); na_head_c(x, gk, lane & 3); *(u32x4*)(pa + 1024) = pack8(x); *(u32x4*)(pa + 1032) = pack8(x + 8);
        if (has2) {
            unpack8(qb0, x); unpack8(qb1, x + 8); na_head_c(x, gq, lane & 3); *(u32x4*)pb = pack8(x); *(u32x4*)(pb + 8) = pack8(x + 8);
            unpack8(kb0, x); unpack8(kb1, x + 8); na_head_c(x, gk, lane & 3); *(u32x4*)(pb + 1024) = pack8(x); *(u32x4*)(pb + 1032) = pack8(x + 8);
        }
    }
}

namespace att {
#define SBAR() __builtin_amdgcn_sched_barrier(0)
__device__ __forceinline__ int crow(int r, int hi) { return (r & 3) + 8 * (r >> 2) + 4 * hi; }
template <int HD> __device__ __forceinline__ int kswz(int row, int colB) { if constexpr (HD == 128) return row * 256 + (colB ^ ((row & 7) << 4)); else return row * 128 + (colB ^ (((row >> 1) & 7) << 4)); }
template <int HD> __device__ __forceinline__ int v_st(int k, int c) { const int kk = (k & ~0xC) | ((k & 4) << 1) | ((k & 8) >> 1); return ((kk >> 3) * (HD / 32) + (c >> 5)) * 512 + ((kk & 7) * 32 + (c & 31)) * 2; }
__device__ __forceinline__ int v_rd_base(int lane) { return ((lane & 3) << 3) | (((lane >> 2) & 3) << 6) | (((lane >> 4) & 1) << 5) | (((lane >> 5) & 1) << 8); }
template <int HD> constexpr int v_rd_off(int d0, int ks, int half) { return d0 * 512 + ks * (HD * 32) + half * (HD * 16); }
template <int OFF> __device__ __forceinline__ s16x4 tr_read(int vb) { s16x4 r; asm volatile("ds_read_b64_tr_b16 %0, %1 offset:%2" : "=&v"(r) : "v"(vb), "i"(OFF) : "memory"); return r; }

__device__ __forceinline__ void partialSM(f32x16& p0, f32x16& p1, float& m_reg, float& mn, float& alpha, const float C, const float THRS) {
    float pmax = p0[0];
#pragma unroll
    for (int r = 1; r < 16; ++r) pmax = fmaxf(pmax, p0[r]);
#pragma unroll
    for (int r = 0; r < 16; ++r) pmax = fmaxf(pmax, p1[r]);
    { auto rr = __builtin_amdgcn_permlane32_swap(__float_as_uint(pmax), __float_as_uint(pmax), false, false); pmax = fmaxf(__uint_as_float(rr[0]), __uint_as_float(rr[1])); }
    if (__builtin_expect(__all(pmax - m_reg <= THRS), 1)) { mn = m_reg; alpha = 1.f; }
    else { mn = fmaxf(m_reg, pmax); alpha = __builtin_amdgcn_exp2f((m_reg - mn) * C); m_reg = mn; }
    const float mnC = -mn * C;
#pragma unroll
    for (int r = 0; r < 16; ++r) p0[r] = fmaf(p0[r], C, mnC);
#pragma unroll
    for (int r = 0; r < 16; ++r) p1[r] = fmaf(p1[r], C, mnC);
#pragma unroll
    for (int r = 0; r < 16; ++r) p0[r] = __builtin_amdgcn_exp2f(p0[r]);
}
__device__ __forceinline__ void finishSM(f32x16& p0, f32x16& p1, float alpha, float& l_reg, bf16x8& pa0, bf16x8& pa1, bf16x8& pa2, bf16x8& pa3) {
#pragma unroll
    for (int r = 0; r < 16; ++r) p1[r] = __builtin_amdgcn_exp2f(p1[r]);
    float ps = 0;
#pragma unroll
    for (int r = 0; r < 16; ++r) ps += p0[r];
#pragma unroll
    for (int r = 0; r < 16; ++r) ps += p1[r];
    { auto rr = __builtin_amdgcn_permlane32_swap(__float_as_uint(ps), __float_as_uint(ps), false, false); ps = __uint_as_float(rr[0]) + __uint_as_float(rr[1]); }
    l_reg = l_reg * alpha + ps;
#define PK4(P, BASE, OUT) do { unsigned a0 = cvt_pk_bf16(P[BASE + 0], P[BASE + 1]), a1 = cvt_pk_bf16(P[BASE + 2], P[BASE + 3]);   \
    unsigned b0 = cvt_pk_bf16(P[BASE + 4], P[BASE + 5]), b1 = cvt_pk_bf16(P[BASE + 6], P[BASE + 7]);                              \
    auto r0 = __builtin_amdgcn_permlane32_swap(a0, b0, false, false); auto r1 = __builtin_amdgcn_permlane32_swap(a1, b1, false, false); \
    u32x4 w = {r0[0], r1[0], r0[1], r1[1]}; OUT = *reinterpret_cast<bf16x8*>(&w); } while (0)
    PK4(p0, 0, pa0); PK4(p0, 8, pa1); PK4(p1, 0, pa2); PK4(p1, 8, pa3);
#undef PK4
}
template <int HD> __device__ __forceinline__ void qkt(f32x16& p0, f32x16& p1, const char* Ks, const bf16x8* qr, int r32, int hi) {
    p0 = f32x16{}; p1 = f32x16{};
#pragma unroll
    for (int d0 = 0; d0 < HD / 16; ++d0) { const int cb = (d0 * 16 + hi * 8) * 2;
        const bf16x8 b0 = *reinterpret_cast<const bf16x8*>(Ks + kswz<HD>(r32, cb));
        const bf16x8 b1 = *reinterpret_cast<const bf16x8*>(Ks + kswz<HD>(32 + r32, cb));
        p0 = __builtin_amdgcn_mfma_f32_32x32x16_bf16(b0, qr[d0], p0, 0, 0, 0);
        p1 = __builtin_amdgcn_mfma_f32_32x32x16_bf16(b1, qr[d0], p1, 0, 0, 0); }
}
template <int HD, int D0> __device__ __forceinline__ void pv_one(f32x16& od, int vb, bf16x8 pa0, bf16x8 pa1, bf16x8 pa2, bf16x8 pa3) {
    const s16x4 l0 = tr_read<v_rd_off<HD>(D0, 0, 0)>(vb), h0 = tr_read<v_rd_off<HD>(D0, 0, 1)>(vb), l1 = tr_read<v_rd_off<HD>(D0, 1, 0)>(vb), h1 = tr_read<v_rd_off<HD>(D0, 1, 1)>(vb);
    const s16x4 l2 = tr_read<v_rd_off<HD>(D0, 2, 0)>(vb), h2 = tr_read<v_rd_off<HD>(D0, 2, 1)>(vb), l3 = tr_read<v_rd_off<HD>(D0, 3, 0)>(vb), h3 = tr_read<v_rd_off<HD>(D0, 3, 1)>(vb);
    asm volatile("s_waitcnt lgkmcnt(0)" ::: "memory"); SBAR();
#define PK(L, H) (bf16x8){L[0], L[1], L[2], L[3], H[0], H[1], H[2], H[3]}
    od = __builtin_amdgcn_mfma_f32_32x32x16_bf16(pa0, PK(l0, h0), od, 0, 0, 0);
    od = __builtin_amdgcn_mfma_f32_32x32x16_bf16(pa1, PK(l1, h1), od, 0, 0, 0);
    od = __builtin_amdgcn_mfma_f32_32x32x16_bf16(pa2, PK(l2, h2), od, 0, 0, 0);
    od = __builtin_amdgcn_mfma_f32_32x32x16_bf16(pa3, PK(l3, h3), od, 0, 0, 0);
#undef PK
}
template <int HD> __device__ __forceinline__ void pv_d0(f32x16* o, int vb, bf16x8 pa0, bf16x8 pa1, bf16x8 pa2, bf16x8 pa3) {
    pv_one<HD, 0>(o[0], vb, pa0, pa1, pa2, pa3); pv_one<HD, 1>(o[1], vb, pa0, pa1, pa2, pa3);
    if constexpr (HD == 128) { pv_one<HD, 2>(o[2], vb, pa0, pa1, pa2, pa3); pv_one<HD, 3>(o[3], vb, pa0, pa1, pa2, pa3); }
}
__device__ __forceinline__ void na_mask(f32x16& p0, f32x16& p1, const float* btab, int kr, int rq, int c, int hi) {
    const int rs = min(max(rq - 4, 0), 56), cs = min(max(c - 8, 0), 48);
    const bool rowok = (kr >= rs) && (kr < rs + 8);
    const float* brow = btab + (kr - rq + 7) * 31 - c + 15;
#pragma unroll
    for (int r = 0; r < 16; ++r) { const int kc = crow(r, hi);
        const bool ok0 = rowok && ((unsigned)(kc - cs) < 16u), ok1 = rowok && ((unsigned)(kc + 32 - cs) < 16u);
        p0[r] = ok0 ? p0[r] + brow[kc] : -1e30f; p1[r] = ok1 ? p1[r] + brow[kc + 32] : -1e30f; }
}
template <int HD, int LDI, bool NA>
__device__ __forceinline__ void attn_unit(const bf16_t* __restrict__ Qb, const bf16_t* __restrict__ Kc, const bf16_t* __restrict__ Vc, int rowA, int nA, int rowB, int NT,
                                          bf16_t* __restrict__ Ob, char* lds, const float SCALE, const float* rpb_h, int r0, int kstart, int nmask0) {
    constexpr int SHM = 64 * HD * 2, NO = HD / 32, NQ = HD / 16;
    const float C = SCALE * 1.4426950408889634f, THRS = 8.f / SCALE;
    const int tid = opq((int)threadIdx.x), wid = tid >> 6, lane = tid & 63, r32 = lane & 31, hi = lane >> 5;
    char* V_lds = lds; char* K_lds = lds + 2 * SHM;
    float* ws = (float*)(lds + 4 * SHM) + wid * 64; float* li_l = ws; float* al_l = ws + 32;
    float* btab = (float*)(lds + 4 * SHM + 8 * 256);
    __syncthreads();
    if constexpr (NA) { if (rpb_h) { for (int i = tid; i < 465; i += 512) btab[i] = rpb_h[i] * (1.0f / SCALE); } }
    float m_reg = -1e30f, l_reg = 0; f32x16 o[NO]; bf16x8 qr[NQ];
#pragma unroll
    for (int d = 0; d < NO; ++d) o[d] = f32x16{};
    const bf16_t* Qw = Qb + (size_t)(wid * 32 + r32) * LDI + hi * 8;
#pragma unroll
    for (int d0 = 0; d0 < NQ; ++d0) qr[d0] = *reinterpret_cast<const bf16x8*>(Qw + d0 * 16);
    constexpr int TPR = HD / 8;
    const int sr = tid / TPR, sc = (tid % TPR) * 8;
    const int vst0 = v_st<HD>(sr, sc), vst1 = v_st<HD>(32 + sr, sc);
    const int kst0 = kswz<HD>(sr, sc * 2), kst1 = kswz<HD>(32 + sr, sc * 2);
    const int vb0 = (int)(uintptr_t)V_lds + v_rd_base(lane);
    const int rq = r0 + (wid >> 1), cq = (wid & 1) * 32 + r32;
    bf16x8 s0v0, s0v1, s0k0, s0k1, s1v0, s1v1, s1k0, s1k1;
#define TROW(j) ((j) < nA ? rowA + 64 * (j) : rowB + 64 * ((j) - nA))
#define SLOAD(V0, V1, K0, K1, j) do { const size_t g_ = (size_t)(TROW(j) + sr) * LDI + sc; V0 = *reinterpret_cast<const bf16x8*>(Vc + g_); K0 = *reinterpret_cast<const bf16x8*>(Kc + g_); \
        if constexpr (HD == 128) { V1 = *reinterpret_cast<const bf16x8*>(Vc + g_ + (size_t)32 * LDI); K1 = *reinterpret_cast<const bf16x8*>(Kc + g_ + (size_t)32 * LDI); } } while (0)
#define SWRITE(b, V0, V1, K0, K1) do { *(bf16x8*)(V_lds + (b) * SHM + vst0) = V0; *(bf16x8*)(K_lds + (b) * SHM + kst0) = K0; \
        if constexpr (HD == 128) { *(bf16x8*)(V_lds + (b) * SHM + vst1) = V1; *(bf16x8*)(K_lds + (b) * SHM + kst1) = K1; } } while (0)
#define RESC(a) do { if (__any((a) < 1.f)) { if (hi == 0) al_l[r32] = (a); asm volatile("s_waitcnt lgkmcnt(0)" ::: "memory"); \
        _Pragma("unroll") for (int d = 0; d < NO; ++d) _Pragma("unroll") for (int r = 0; r < 16; ++r) o[d][r] *= al_l[crow(r, hi)]; } } while (0)
#define MASK(P0, P1, j) do { if constexpr (NA) { if ((j) >= nmask0) na_mask(P0, P1, btab, kstart + (j) - nmask0, rq, cq, hi); } } while (0)
    f32x16 pA0, pA1, pB0, pB1; float mnA, mnB, alA, alB; bf16x8 pa0, pa1, pa2, pa3;
    const int rsq_ = __builtin_amdgcn_readfirstlane(min(max(rq - 4, 0), 56));
#define ROWOK(j) (!NA || (j) < nmask0 || ((unsigned)(kstart + (j) - nmask0 - rsq_) < 8u))
#define QKT(P0, P1, OK, KP, j) do { OK = ROWOK(j); if (OK) qkt<HD>(P0, P1, KP, qr, r32, hi); } while (0)
#define PSM(P0, P1, OK, MN, AL, j) do { if (OK) { MASK(P0, P1, j); partialSM(P0, P1, m_reg, MN, AL, C, THRS); } else { MN = m_reg; AL = 1.f; } } while (0)
#define FSM(P0, P1, OK, AL) do { if (OK) finishSM(P0, P1, AL, l_reg, pa0, pa1, pa2, pa3); } while (0)
#define PVD(VB, OK) do { if (OK) pv_d0<HD>(o, VB, pa0, pa1, pa2, pa3); } while (0)
    bool okA = true, okB = true;
    SLOAD(s0v0, s0v1, s0k0, s0k1, 0); SWRITE(0, s0v0, s0v1, s0k0, s0k1); __syncthreads();
    QKT(pA0, pA1, okA, K_lds, 0); PSM(pA0, pA1, okA, mnA, alA, 0);
    SLOAD(s1v0, s1v1, s1k0, s1k1, 1); if (2 < NT) SLOAD(s0v0, s0v1, s0k0, s0k1, 2);
    SWRITE(1, s1v0, s1v1, s1k0, s1k1); __syncthreads();
    for (int j = 1; j + 1 < NT; j += 2) {
        SBAR(); QKT(pB0, pB1, okB, K_lds + SHM, j);
        FSM(pA0, pA1, okA, alA); SBAR();
        SLOAD(s1v0, s1v1, s1k0, s1k1, j + 2); SBAR();
        PVD(vb0, okA); PSM(pB0, pB1, okB, mnB, alB, j);
        __syncthreads(); SWRITE(0, s0v0, s0v1, s0k0, s0k1);
        RESC(alB); __syncthreads();
        SBAR(); QKT(pA0, pA1, okA, K_lds, j + 1);
        FSM(pB0, pB1, okB, alB); SBAR();
        if (j + 3 < NT) SLOAD(s0v0, s0v1, s0k0, s0k1, j + 3); SBAR();
        PVD(vb0 + SHM, okB); PSM(pA0, pA1, okA, mnA, alA, j + 1);
        __syncthreads(); SWRITE(1, s1v0, s1v1, s1k0, s1k1);
        RESC(alA); __syncthreads();
    }
    SBAR(); QKT(pB0, pB1, okB, K_lds + SHM, NT - 1);
    FSM(pA0, pA1, okA, alA); SBAR();
    PVD(vb0, okA); PSM(pB0, pB1, okB, mnB, alB, NT - 1);
    __syncthreads(); RESC(alB);
    FSM(pB0, pB1, okB, alB); SBAR();
    PVD(vb0 + SHM, okB);
    if (hi == 0) li_l[r32] = l_reg; asm volatile("s_waitcnt lgkmcnt(0)" ::: "memory");
    float rli[16];
#pragma unroll
    for (int r = 0; r < 16; ++r) rli[r] = __builtin_amdgcn_rcpf(li_l[crow(r, hi)]);
    bf16_t* Ow = Ob + (size_t)(wid * 32) * 1024;
#pragma unroll
    for (int r = 0; r < 16; ++r) { const int orow = crow(r, hi);
#pragma unroll
        for (int d0 = 0; d0 < NO; ++d0) { const float val = o[d0][r] * rli[r]; Ow[(size_t)orow * 1024 + d0 * 32 + r32] = (bf16_t)(cvt_pk_bf16(val, val) & 0xffffu); } }
#undef TROW
#undef SLOAD
#undef SWRITE
#undef RESC
#undef MASK
#undef ROWOK
#undef QKT
#undef PSM
#undef FSM
#undef PVD
}
#undef SBAR
}

__device__ __forceinline__ void phase_attn_gqa(bf16_t* QKV, bf16_t* O, char* lds) {
    const int G = gridDim.x, bid = blockIdx.x;
    for (int i = 0; ; ++i) {
        int b, hq, qb; bool ctxu = false;
        if (G == 256) { const int x = bid & 7, k = bid >> 3;
            if (i < 2) { const int ug = i * 32 + k; b = x >> 1; hq = (x & 1) * 4 + (ug >> 4); qb = ug & 15; }
            else if (i == 2 && bid < 32) { ctxu = true; hq = bid & 7; b = bid >> 3; qb = 0; } else break;
        } else { const int u = bid + i * G; if (u >= 544) break;
            if (u < 512) { qb = u & 15; hq = (u >> 4) & 7; b = u >> 7; } else { ctxu = true; const int v = u - 512; hq = v & 7; b = v >> 3; qb = 0; } }
        const int kvh = hq >> 2, row0 = ctxu ? NLAT + b * CTXL : b * SEQ + qb * 256;
        const int rowA = ctxu ? NLAT + b * CTXL : b * SEQ, nA = ctxu ? 4 : 64, rowB = NLAT + b * CTXL, NT = ctxu ? 4 : 68;
        att::attn_unit<128, 1536, false>(QKV + (size_t)row0 * 1536 + hq * 128, QKV + 1024 + kvh * 128, QKV + 1280 + kvh * 128, rowA, nA, rowB, NT,
                                         O + (size_t)row0 * 1024 + hq * 128, lds, 0.08838834764831845f, nullptr, 0, 0, 1 << 30);
    }
}
__device__ __forceinline__ void phase_attn_na(const PV p, bf16_t* QKV, bf16_t* O, char* lds) {
    const int G = gridDim.x, bid = blockIdx.x;
    const float* rpb = PIN(I_RPB);
    for (int i = 0; ; ++i) {
        int b, h, rg; bool ctxu = false;
        if (G == 256) { const int x = bid & 7, k = bid >> 3;
            if (i < 4) { const int ug = i * 32 + k, grp = x + 8 * (ug >> 4); b = grp >> 4; h = grp & 15; rg = ug & 15; }
            else if (i == 4 && bid < 64) { ctxu = true; h = bid & 15; b = bid >> 4; rg = 0; } else break;
        } else { const int u = bid + i * G; if (u >= 1088) break;
            if (u < 1024) { rg = u & 15; h = (u >> 4) & 15; b = u >> 8; } else { ctxu = true; const int v = u - 1024; h = v & 15; b = v >> 4; rg = 0; } }
        const int r0 = rg * 4, kstart = min(max(r0 - 4, 0), 52);
        const int row0 = ctxu ? NLAT + b * CTXL : b * SEQ + rg * 256, rowA = NLAT + b * CTXL, rowB = b * SEQ + kstart * 64, NT = ctxu ? 4 : 16;
        att::attn_unit<64, 3072, true>(QKV + (size_t)row0 * 3072 + h * 64, QKV + 1024 + h * 64, QKV + 2048 + h * 64, rowA, 4, rowB, NT,
                                       O + (size_t)row0 * 1024 + h * 64, lds, 0.125f, ctxu ? nullptr : rpb + h * 465, r0, kstart, ctxu ? (1 << 30) : 4);
    }
}

template <class Epi> __device__ __forceinline__ void run_gemm(LAS unsigned char* lds, const bf16_t* A, const bf16_t* Bt, int M, int N, int K, int lda, int mode, const Epi& E) {
    pg8::Gemm g{A, Bt, M, N, K, lda}; pg8::GenOrder S; S.init(M, N, K, (int)gridDim.x, (int)blockIdx.x, mode); S.caoff = (long)((WS_C - WS_A) / 2); S.act = (long)ACT;
    pg8::gemm_phase<Epi, pg8::GenOrder, true, true>(lds, g, S, E);
}

#define RLX_AGENT __ATOMIC_RELAXED, __HIP_MEMORY_SCOPE_AGENT
#define XB_TMO      128
#define XB_XCNT(j)  (256  + 64 * (j))
#define XB_XSUB(j)  (1280 + 64 * (j))
#define XB_XGEN(j)  (2304 + 64 * (j))
#define XB_TOP      3328
#define XB_TOPGEN   3392
#define XCD_BAR_WORDS 3456
#define XB_SPIN_CAP (1u << 18)

__device__ __forceinline__ unsigned xb_ld(unsigned* p)              { return __hip_atomic_load(p, __ATOMIC_RELAXED, __HIP_MEMORY_SCOPE_AGENT); }
__device__ __forceinline__ unsigned xb_add(unsigned* p, unsigned v) { return __hip_atomic_fetch_add(p, v, __ATOMIC_RELAXED, __HIP_MEMORY_SCOPE_AGENT); }
__device__ __forceinline__ unsigned xb_xcc_id() { return (unsigned)__builtin_amdgcn_s_getreg((3 << 11) | 20) & 0xFu; }
#define XB_SPIN(cond, bar) do { unsigned _sp = 0; while (cond) { __builtin_amdgcn_s_sleep(1); \
    if ((++_sp & 255u) == 0u) { if (xb_ld(&(bar)[XB_TMO])) break; if (_sp > XB_SPIN_CAP) { atomicAdd(&(bar)[XB_TMO], 1u); break; } } } } while (0)

struct XcdBarrier {
    unsigned* bar; unsigned x;
    volatile LAS unsigned* st;
};

__device__ __forceinline__ XcdBarrier xcd_barrier_post(unsigned* bar, volatile LAS unsigned* st) {
    XcdBarrier b; b.bar = bar; b.x = xb_xcc_id(); b.st = st;
    if (threadIdx.x == 0) (void)xb_add(&bar[XB_XCNT(b.x)], 1u);
    return b;
}
__device__ __forceinline__ void xcd_barrier_complete(unsigned* bar, unsigned x, unsigned& nloc, unsigned& nx) {
    const unsigned G = gridDim.x * gridDim.y * gridDim.z;
    unsigned sum, cnt, mine, sp = 0u;
    for (;;) {
        sum = 0u; cnt = 0u; mine = 0u;
#pragma unroll
        for (unsigned j = 0; j < 16; ++j) { const unsigned c = xb_ld(&bar[XB_XCNT(j)]); sum += c; cnt += (c > 0u) ? 1u : 0u; mine = (j == x) ? c : mine; }
        if (sum == G) break;
        __builtin_amdgcn_s_sleep(1);
        if ((++sp & 255u) == 0u) { if (xb_ld(&bar[XB_TMO])) break; if (sp > XB_SPIN_CAP) { atomicAdd(&bar[XB_TMO], 1u); break; } }
    }
    nloc = mine > 0u ? mine : 1u; nx = cnt > 0u ? cnt : 1u;
}

__device__ __forceinline__ void xcd_barrier(const XcdBarrier& b) {
    asm volatile("s_waitcnt vmcnt(0)" ::: "memory");
    __syncthreads();
    if (threadIdx.x == 0) {
        unsigned* bar = b.bar;
        __builtin_amdgcn_s_waitcnt(0);
        unsigned nloc = b.st[0], nx = b.st[1];
        if (nloc == 0u) { xcd_barrier_complete(bar, b.x, nloc, nx); b.st[0] = nloc; b.st[1] = nx; }
        const unsigned old = xb_add(&bar[XB_XSUB(b.x)], 1u);
        const unsigned gen = old / nloc;
        if (old + 1u == (gen + 1u) * nloc) {
            __builtin_amdgcn_fence(__ATOMIC_RELEASE, "agent");
            asm volatile("s_waitcnt vmcnt(0)" ::: "memory");
            const unsigned og = xb_add(&bar[XB_TOP], 1u);
            const unsigned tg = og / nx;
            if (og + 1u == (tg + 1u) * nx) xb_add(&bar[XB_TOPGEN], 1u);
            else XB_SPIN(xb_ld(&bar[XB_TOPGEN]) == tg, bar);
            __builtin_amdgcn_fence(__ATOMIC_ACQUIRE, "agent");
            xb_add(&bar[XB_XGEN(b.x)], 1u);
            asm volatile("s_waitcnt vmcnt(0)" ::: "memory");
        } else {
            XB_SPIN(xb_ld(&bar[XB_XGEN(b.x)]) == gen, bar);
            __builtin_amdgcn_fence(__ATOMIC_ACQUIRE, "agent");
            asm volatile("s_waitcnt vmcnt(0)" ::: "memory");
        }
    }
    __syncthreads();
}

constexpr size_t WS_BAR = 768 * 1024;
constexpr int LDS_BARST = LDS_BYTES - 64;
#ifndef PROBE_KIND
#define PROBE_KIND 0
#endif
__device__ __forceinline__ bool probe_hit(int ph) {
    int L = 0, s = -1;
    if (ph >= 1) { const int q = ph - 1; if (q < 9) { L = 0; s = q; } else if (q < 17) { L = 1; s = q - 9; } else if (q < 25) { L = 2; s = q - 17; } else { L = 3; s = q - 25; } }
    const bool rw = (L == 0 || L == 3);
    if (PROBE_KIND == 1) return rw && s == 3;
    if (PROBE_KIND == 2) return !rw && s == 3;
    if (PROBE_KIND == 3) return rw && (s == 1 || s == 2);
    if (PROBE_KIND == 4) return (s == 0) || (rw && s == 6) || (!rw && s == 5);
    if (PROBE_KIND == 5) return (rw && s == 7) || (!rw && s == 6);
    if (PROBE_KIND == 6) return (rw && s == 4) || (!rw && s == 2) || ph == 0;
    return false;
}
__device__ __forceinline__ unsigned char* wsq_() { int z; asm volatile("s_mov_b32 %0, 0" : "=s"(z)); return (unsigned char*)pin(41, z); }
__device__ __forceinline__ unsigned char* obq_() { int z; asm volatile("s_mov_b32 %0, 0" : "=s"(z)); return (unsigned char*)pin(40, z); }
#define WSQ (wsq_())
#define OBQ (obq_())
#define Q_MOD ((float*)(WSQ + WS_MOD))
#define Q_H ((float*)(WSQ + WS_H))
#define Q_RA ((bf16_t*)(WSQ + WS_A))
#define Q_RB ((bf16_t*)(WSQ + WS_B))
#define Q_RC ((bf16_t*)(WSQ + WS_C))
#define QR_W1b ((bf16_t*)(OBQ + 34 * MiB))
#define QR_HL ((bf16_t*)(OBQ + 48 * MiB))
#define QR_G ((bf16_t*)OBQ)
#define QR_W2b ((bf16_t*)(WSQ + WS_S))
#define QR_Wo ((bf16_t*)(WSQ + WS_S + 3840 * 1024))
#define QR_COEF ((float*)(WSQ + WS_S + 6 * MiB))
#define QR_W2t ((bf16_t*)(WSQ + WS_B + 11 * MiB))
#define QA_Wqkv ((bf16_t*)(WSQ + WS_ATTW))
#define QA_Wo ((bf16_t*)(WSQ + WS_ATTW + 6 * MiB))
#define QA_W13 ((bf16_t*)(WSQ + WS_ATTW + 8 * MiB))
#define QA_W2t ((bf16_t*)(WSQ + WS_ATTW + 19 * MiB))
__global__ void __launch_bounds__(512, 2) mega(Params kp) {
    extern __shared__ __attribute__((aligned(16))) unsigned char lds_raw[];
    LAS unsigned char* lds = (LAS unsigned char*)lds_raw;
    const int ph_lo = kp.ph_lo, ph_hi = kp.ph_hi;
    if (ph_hi - ph_lo > 1) {
        if (threadIdx.x < 2) ((LAS unsigned*)(lds + LDS_BARST))[threadIdx.x] = 0u;
        __syncthreads();
        (void)xcd_barrier_post((unsigned*)(kp.ws + WS_BAR), (volatile LAS unsigned*)(lds + LDS_BARST));
    }
#if PROBE_KIND
    int rep = 0;
#endif
    for (int ph = ph_lo; ph < ph_hi; ++ph) {
        PV p; asm volatile("s_mov_b32 %0, 0" : "=s"(p.z));
#define WIDS const int tid_ = opq((int)threadIdx.x); const int lane = tid_ & 63; const int gw = blockIdx.x * 8 + (tid_ >> 6); const int ngw = gridDim.x * 8;
        int L = 0, s = 0;
        if (ph >= 1) { const int q = ph - 1; if (q < 9) { L = 0; s = q; } else if (q < 17) { L = 1; s = q - 9; } else if (q < 25) { L = 2; s = q - 17; } else { L = 3; s = q - 25; } }
        int gsel = 0; const bf16_t* gA = nullptr; const bf16_t* gB = nullptr; int gM = 0, gN = 0, gK = 0, gmode = 0;
        pg8::EpiStore es; es.O = nullptr; es.ldc = 0; es.split_cols = 0; es.split_stride = 0; es.Oalt = nullptr; es.talt = -1; es.HL = nullptr; es.rw1 = 0;
        pg8::EpiRes er; er.base_lat = nullptr; er.base_ctx = nullptr; er.out = nullptr; er.gate = nullptr; er.part = (float*)(WSQ + WS_B + 20 * MiB);
        const float* PART = (const float*)(WSQ + WS_B + 20 * MiB);
        pg8::EpiSwiglu eg; eg.U = nullptr; eg.ldu = DFF;
        const float* modl = Q_MOD + (size_t)L * 5 * 6144;
        if (ph == 0) {
            phase_mod(p, (LAS float*)lds, Q_MOD);
        } else if (L == 0 || L == 3) {
            const int j = (L == 3) ? 1 : 0; const int Mr = (L < 3) ? MT : NLAT;
            switch (s) {
            case 0: { WIDS; cvt_rwkv_mixer(p, j, QR_W1b, QR_W2b, QR_Wo, gw, ngw, lane);
                    const float* hb_lat = (L == 0) ? PIN(I_X) : Q_H; const float* hb_ctx = (L == 0) ? (PIN(I_CTX) - (size_t)NLAT * D) : Q_H;
                    if (L == 0) { const float* cx = PIN(I_CTX); for (int i = gw * 64 + lane; i < NCTX * D / 4; i += ngw * 64) ((f32x4*)(Q_H + (size_t)NLAT * D))[i] = ((const f32x4*)cx)[i]; }
                    phase_norm_shift(hb_lat, hb_ctx, PIN(I_NMIX) + L * D, modl, PIN(I_MU) + (size_t)j * 6 * D, Q_RA, Q_RC, gw, ngw, lane); } break;
            case 1: gsel = 1; gA = Q_RA; gB = QR_W1b; gM = MT; gN = 3840; gK = 1024; gmode = 1; es.O = Q_RB; es.ldc = 1024; es.split_cols = 1024; es.split_stride = ACT; es.HL = QR_HL; es.rw1 = 1; break;
            case 2: gsel = 1; gA = QR_HL; gB = QR_W2b; gM = MT; gN = 5120; gK = 384; gmode = 3; es.O = Q_RC; es.ldc = 1024; es.split_cols = 1024; es.split_stride = ACT; es.Oalt = QR_G; es.talt = 4; break;
#ifndef NO_SCAN
            case 3: phase_scan(p, j, lds, Q_RB, (Q_RB + ACT), (Q_RB + 2 * ACT), Q_RC, Q_RC + 2 * ACT, Q_RA, QR_COEF); break;
#endif
            case 4: { WIDS; cvt_ffn(p, L, Q_RB, QR_W2t, gw, ngw, lane);
                    phase_readout(p, j, Q_RA, (Q_RB + 2 * ACT), QR_G, QR_COEF, Q_RC, Mr, gw, ngw, lane); } break;
            case 5: gsel = 2; gA = Q_RC; gB = QR_Wo; gM = Mr; gN = 1024; gK = 1024; gmode = 2; er.base_lat = (L == 0) ? PIN(I_X) : Q_H; er.base_ctx = (L == 0) ? (PIN(I_CTX) - (size_t)NLAT * D) : Q_H; er.out = Q_H; er.gate = modl + 2048; break;
            case 6: { WIDS; phase_norm(Q_H, Q_H, PIN(I_NFFN) + L * D, modl, 3072, 4096, Q_RA, Mr, gw, ngw, lane, Q_H, PART, (L < 3) ? 4 : 0); } break;
            case 7: gsel = 3; gA = Q_RA; gB = Q_RB; gM = Mr; gN = 5632; gK = 1024; eg.U = Q_RC; break;
            default: gsel = 2; gA = Q_RC; gB = QR_W2t; gM = Mr; gN = 1024; gK = DFF; gmode = (L == 0) ? 2 : 0; er.base_lat = Q_H; er.base_ctx = Q_H; er.out = (L == 3) ? (float*)OBQ : Q_H; er.gate = modl + 5120; break;
            }
        } else {
            const bool gqa = (L == 1); const int NQ = gqa ? 1536 : 3072;
            switch (s) {
            case 0: { WIDS; int gwc = gw;
                if (gqa) { cvt_run(mkjob(PIN(I_AWQ), nullptr, QA_Wqkv, D, 1024, 1024, 0, 0, 0), gwc, ngw, lane); cvt_run(mkjob(PIN(I_AWK), nullptr, QA_Wqkv, D, 256, 1024, 0, 1024, 0), gwc, ngw, lane);
                           cvt_run(mkjob(PIN(I_AWV), nullptr, QA_Wqkv, D, 256, 1024, 0, 1280, 0), gwc, ngw, lane); cvt_run(mkjob(PIN(I_AWO), nullptr, QA_Wo, D, D, 1024, 0, 0, 0), gwc, ngw, lane); }
                else { cvt_run(mkjob(PIN(I_NWQKV), nullptr, QA_Wqkv, D, 3072, 1024, 0, 0, 0), gwc, ngw, lane); cvt_run(mkjob(PIN(I_NWO), nullptr, QA_Wo, D, D, 1024, 0, 0, 0), gwc, ngw, lane); }
                cvt_ffn(p, L, QA_W13, QA_W2t, gw, ngw, lane);
                phase_norm(Q_H, Q_H, PIN(I_NMIX) + L * D, modl, 0, 1024, Q_RA, MT, gw, ngw, lane, Q_H, PART, 11); } break;
            case 1: gsel = 1; gA = Q_RA; gB = QA_Wqkv; gM = MT; gN = NQ; gK = 1024; es.O = Q_RB; es.ldc = NQ; break;
            case 2: { WIDS; if (gqa) phase_qknorm_gqa(p, Q_RB, gw, ngw, lane); else phase_qknorm_na(p, Q_RB, gw, ngw, lane); } break;
#ifndef NO_ATT
            case 3: if (gqa) phase_attn_gqa(Q_RB, (Q_RA + ACT), (char*)lds_raw); else phase_attn_na(p, Q_RB, (Q_RA + ACT), (char*)lds_raw); break;
#endif
            case 4: gsel = 2; gA = (Q_RA + ACT); gB = QA_Wo; gM = MT; gN = 1024; gK = 1024; gmode = 2; er.base_lat = Q_H; er.base_ctx = Q_H; er.out = Q_H; er.gate = modl + 2048; break;
            case 5: { WIDS; phase_norm(Q_H, Q_H, PIN(I_NFFN) + L * D, modl, 3072, 4096, Q_RA, MT, gw, ngw, lane, Q_H, PART, 4); } break;
            case 6: gsel = 3; gA = Q_RA; gB = QA_W13; gM = MT; gN = 5632; gK = 1024; eg.U = Q_RC; break;
            default: gsel = 2; gA = Q_RC; gB = QA_W2t; gM = MT; gN = 1024; gK = DFF; gmode = (L == 1) ? 2 : 0; er.base_lat = Q_H; er.base_ctx = Q_H; er.out = Q_H; er.gate = modl + 5120; break;
            }
        }
#ifndef NO_GEMM
        if (gsel == 1) run_gemm<pg8::EpiStore>(lds, gA, gB, gM, gN, gK, gK, gmode, es);
        else if (gsel == 2) run_gemm<pg8::EpiRes>(lds, gA, gB, gM, gN, gK, gK, gmode, er);
        else if (gsel == 3) run_gemm<pg8::EpiSwiglu>(lds, gA, gB, gM, gN, gK, gK, gmode, eg);
#endif
#if PROBE_KIND
        if (rep == 0 && probe_hit(ph)) { rep = 1; cg::this_grid().sync(); --ph; continue; }
        rep = 0;
#endif
        if (ph + 1 < ph_hi) { if (ph_lo < 0) cg::this_grid().sync(); else { XcdBarrier bar; bar.bar = (unsigned*)(WSQ + WS_BAR); bar.x = xb_xcc_id(); bar.st = (volatile LAS unsigned*)(lds + LDS_BARST); xcd_barrier(bar); } }
    }
}

extern "C" void kernel_launch(void* const* d_in, const int* in_sizes, int n_in, void* d_out, int out_size, void* d_ws, size_t ws_size, hipStream_t stream) {
    static int grid = 0;
    if (grid == 0) {
        if (n_in != 40 || out_size != NLAT * D || ws_size < WS_END) { fprintf(stderr, "kernel_launch: unexpected shapes: n_in %d out %d ws %zu (need >= %zu)\n", n_in, out_size, ws_size, (size_t)WS_END); grid = -1; return; }
        int dev = 0, cus = 0, per_cu = 0;
        if (hipGetDevice(&dev) != hipSuccess || hipDeviceGetAttribute(&cus, hipDeviceAttributeMultiprocessorCount, dev) != hipSuccess) { grid = -1; return; }
        if (hipFuncSetAttribute((const void*)mega, hipFuncAttributeMaxDynamicSharedMemorySize, LDS_BYTES) != hipSuccess) { fprintf(stderr, "kernel_launch: hipFuncSetAttribute failed\n"); grid = -1; return; }
        if (hipOccupancyMaxActiveBlocksPerMultiprocessor(&per_cu, (const void*)mega, 512, LDS_BYTES) != hipSuccess || per_cu < 1) { fprintf(stderr, "kernel_launch: occupancy query gave %d\n", per_cu); per_cu = 1; }
        (void)hipGetLastError();
        grid = cus * per_cu;
    }
    if (grid < 0) return;
    Params p{};
    for (int i = 0; i < 40; ++i) p.in[i] = (const float*)d_in[i];
    p.out = (float*)d_out; p.ws = (unsigned char*)d_ws;
#if ONE_LAUNCH
    p.ph_lo = 0; p.ph_hi = NPH;
    if (hipMemsetAsync((char*)d_ws + WS_BAR, 0, XCD_BAR_WORDS * 4, stream) != hipSuccess) { fprintf(stderr, "kernel_launch: hipMemsetAsync of the barrier words failed\n"); return; }
    void* args[] = {&p};
    hipError_t e = hipLaunchCooperativeKernel((const void*)mega, dim3(grid), dim3(512), args, LDS_BYTES, stream);
    if (e != hipSuccess) fprintf(stderr, "cooperative launch failed: %s (grid %d)\n", hipGetErrorString(e), grid);
#else
    for (int ph = 0; ph < NPH; ++ph) { p.ph_lo = ph; p.ph_hi = ph + 1; hipLaunchKernelGGL(mega, dim3(grid), dim3(512), LDS_BYTES, stream, p); }
#endif
}
```

```cpp
#include <hip/hip_runtime.h>
#include <hip/hip_cooperative_groups.h>
#include <cstdio>
#include <cstdint>
namespace cg = cooperative_groups;
#ifndef ONE_LAUNCH
#define ONE_LAUNCH 1
#endif
#ifndef PROBE_KIND
#define PROBE_KIND 0
#endif
namespace pg8 {
#define PG8_LAS __attribute__((address_space(3)))
typedef unsigned short bf16_t;
typedef short bf16x8 __attribute__((ext_vector_type(8)));
typedef float f32x4 __attribute__((ext_vector_type(4)));
typedef unsigned u32x4 __attribute__((ext_vector_type(4)));
constexpr int BM = 256, BK = 64, HALF = 128, HTB = HALF * BK * 2  , STAGE_BYTES = 8 * HTB, NXCD = 8, WGM = 8;

__host__ __device__ __forceinline__ int lds_byte(int r, int c) { const int st = (r >> 4) * 2 + (c >> 5), rr = r & 15, cc = c & 31, ob = rr * 64 + cc * 2; return st * 1024 + (ob ^ (((ob >> 9) & 1) << 5)); }
__host__ __device__ __forceinline__ void stage_rc(int b, int& R, int& C) { const int st = b / 1024, sb = b % 1024, swz = sb ^ (((sb >> 9) & 1) << 5); R = (st >> 1) * 16 + swz / 64; C = (st & 1) * 32 + (swz % 64) / 2; }
__host__ __device__ __forceinline__ int perm32(int rho) { const int n = rho >> 4, i = rho & 15; return 8 * (i >> 2) + 4 * n + (i & 3); }

struct Unit { int pm, pn, k0, nt, split; long aoff; };
struct Gemm { const bf16_t* A; const bf16_t* Bt; int M, N, K, lda; };

struct StaticOrder {
    int nM, nN, nwg, G, c;
    __host__ __device__ void init(int M, int N, int G_, int c_) { nM = M / BM; nN = N / BM; nwg = nM * nN; G = G_; c = c_; }
    __host__ __device__ bool next(int i, Unit& u) const {
        const long L = (long)i * G + c; if (L >= nwg) return false;
        int wgid = (int)L; { const int q = nwg / NXCD, r = nwg % NXCD, xcd = wgid % NXCD, off = wgid / NXCD; wgid = (xcd < r ? xcd * (q + 1) : r * (q + 1) + (xcd - r) * q) + off; }
        const int nig = WGM * nN, gid = wgid / nig, fm = gid * WGM, gsz = (nM - fm) < WGM ? (nM - fm) : WGM;
        u.pm = fm + ((wgid % nig) % gsz); u.pn = (wgid % nig) / gsz; return true;
    }
    __device__ __forceinline__ void a_ready(const Unit&) const {}
    __device__ __forceinline__ void done(const Unit&) const {}
};

struct GenOrder {
    int nM, nN, nwg, G, c, mode, ntf, nsplit; long caoff, act;
    __host__ __device__ void init(int M, int N, int K, int G_, int c_, int mode_) { nM = M / BM; nN = N / BM; G = G_; c = c_; mode = mode_; ntf = K / BK; nsplit = K / 256;
        if (mode == 2 && nM > 64) { nM = 64; } else if (mode == 2) mode = 0; nwg = nM * nN; caoff = 0; act = 0; }
    __host__ __device__ bool next(int i, Unit& u) const {
        const long L = (long)i * G + c; u.k0 = 0; u.nt = ntf; u.split = 0; u.aoff = 0;
        if (L >= nwg) {
            if (mode != 2) return false;
            const int idx = (int)(L - nwg); if (idx >= 4 * nN * nsplit) return false;
            const int tile = idx / nsplit, ks = idx - tile * nsplit; u.pm = 64 + tile / nN; u.pn = tile % nN; u.k0 = ks * 256; u.nt = 4; u.split = 1; return true;
        }
        int wgid = (int)L; { const int q = nwg / NXCD, r = nwg % NXCD, xcd = wgid % NXCD, off = wgid / NXCD; wgid = (xcd < r ? xcd * (q + 1) : r * (q + 1) + (xcd - r) * q) + off; }
        const int nig = WGM * nN, gid = wgid / nig, fm = gid * WGM, gsz = (nM - fm) < WGM ? (nM - fm) : WGM;
        u.pm = fm + ((wgid % nig) % gsz); u.pn = (wgid % nig) / gsz;
        if (mode == 3) { const int rg = u.pn >> 2; u.k0 = rg < 4 ? 64 * rg : 256; u.nt = 2; }
        if (mode == 1) { const int gi = u.pn < 12 ? (u.pn >> 2) : (u.pn - 9); u.aoff = gi < 4 ? caoff + (long)gi * act : (long)(gi - 4) * act; }
        return true;
    }
    __device__ __forceinline__ void a_ready(const Unit&) const {}
    __device__ __forceinline__ void done(const Unit&) const {}
};
__device__ __forceinline__ unsigned cvt_pk_bf16(float lo, float hi) { unsigned r; asm volatile("v_cvt_pk_bf16_f32 %0, %1, %2" : "=v"(r) : "v"(lo), "v"(hi)); return r; }
typedef unsigned u32x2 __attribute__((ext_vector_type(2)));
__device__ __forceinline__ float fsigmoid(float x) { return __builtin_amdgcn_rcpf(1.0f + __expf(-x)); }
__device__ __forceinline__ float ftanh(float x) { return 1.0f - 2.0f * __builtin_amdgcn_rcpf(__expf(2.0f * x) + 1.0f); }
struct EpiStore {
    static constexpr bool PERM = true, AFTER_DRAIN = false;
    bf16_t* O; int ldc; int split_cols; size_t split_stride; bf16_t* Oalt; int talt; bf16_t* HL; int rw1;
    __device__ __forceinline__ void operator()(const f32x4 (&acc)[2][2][4][2], const Unit& u, int wr, int wc, int fr, int fq) const {
        const int row0 = u.pm * BM + wr * 64 + fr; int colt = u.pn * BM; bf16_t* base = O; int ld = ldc; int actsel = 0;
        if (rw1 && u.pn >= 12) { base = HL; ld = 384; colt = (u.pn - 12) * 128; actsel = u.pn - 11; }
        else if (split_cols) { const int t = colt / split_cols; colt -= t * split_cols; if (t == talt) base = Oalt; else base += (size_t)t * split_stride; }
        const int col0 = colt + wc * 32 + 8 * fq;
#pragma unroll
        for (int ai = 0; ai < 2; ++ai)
#pragma unroll
            for (int m = 0; m < 4; ++m) { bf16_t* rowp = base + (size_t)(row0 + ai * HALF + m * 16) * ld + col0;
#pragma unroll
                for (int bj = 0; bj < 2; ++bj) { f32x4 v0 = acc[ai][bj][m][0], v1 = acc[ai][bj][m][1];
                    if (actsel && bj == 1) continue;
                    if (actsel == 1 && bj == 0) {
#pragma unroll
                        for (int j = 0; j < 4; ++j) { v0[j] = ftanh(v0[j]); v1[j] = ftanh(v1[j]); } }
                    if (actsel == 3) {
#pragma unroll
                        for (int j = 0; j < 4; ++j) { v0[j] = fsigmoid(v0[j]); v1[j] = fsigmoid(v1[j]); } }
                    u32x4 w; w.x = cvt_pk_bf16(v0[0], v0[1]); w.y = cvt_pk_bf16(v0[2], v0[3]); w.z = cvt_pk_bf16(v1[0], v1[1]); w.w = cvt_pk_bf16(v1[2], v1[3]);
                    *(u32x4*)(rowp + bj * HALF) = w; } }
    }
};
struct EpiRes {
    static constexpr bool PERM = false, AFTER_DRAIN = false;
    const float* base_lat; const float* base_ctx; float* out; const float* gate; float* part;
    __device__ __forceinline__ void operator()(const f32x4 (&acc)[2][2][4][2], const Unit& u, int wr, int wc, int fr, int fq) const {
        const int bidx = u.pm < 64 ? (u.pm >> 4) : 4; const float* bs = u.pm < 64 ? base_lat : base_ctx; const float* g = gate + bidx * 6144;
        const int col0 = u.pn * BM + wc * 32 + 4 * fq;
#pragma unroll
        for (int bj = 0; bj < 2; ++bj)
#pragma unroll
            for (int n = 0; n < 2; ++n) { const f32x4 gv = *(const f32x4*)(g + col0 + bj * HALF + n * 16);
#pragma unroll
                for (int ai = 0; ai < 2; ++ai) {
#pragma unroll
                    for (int m = 0; m < 4; ++m) { const size_t off = (size_t)(u.pm * BM + ai * HALF + wr * 64 + m * 16 + fr) * 1024 + col0 + bj * HALF + n * 16;
                        if (u.split) { *(f32x4*)(part + (size_t)(u.k0 >> 8) * 1048576 + (off - (size_t)16384 * 1024)) = gv * acc[ai][bj][m][n]; }
                        else { const f32x4 b = *(const f32x4*)(bs + off); *(f32x4*)(out + off) = b + gv * acc[ai][bj][m][n]; } }
                    asm volatile("" ::: "memory"); } }
    }
};
struct EpiSwiglu {
    static constexpr bool PERM = true, AFTER_DRAIN = false;
    bf16_t* U; int ldu;
    __device__ __forceinline__ void operator()(const f32x4 (&acc)[2][2][4][2], const Unit& u, int wr, int wc, int fr, int fq) const {
        const int row0 = u.pm * BM + wr * 64 + fr; const int col0 = u.pn * 128 + wc * 16 + 4 * fq;
#pragma unroll
        for (int ai = 0; ai < 2; ++ai)
#pragma unroll
            for (int m = 0; m < 4; ++m) { bf16_t* rowp = U + (size_t)(row0 + ai * HALF + m * 16) * ldu + col0;
#pragma unroll
                for (int bj = 0; bj < 2; ++bj) { const f32x4 a = acc[ai][bj][m][0], b = acc[ai][bj][m][1]; f32x4 o;
#pragma unroll
                    for (int j = 0; j < 4; ++j) o[j] = a[j] * fsigmoid(a[j]) * b[j];
                    u32x2 w; w.x = cvt_pk_bf16(o[0], o[1]); w.y = cvt_pk_bf16(o[2], o[3]); *(u32x2*)(rowp + bj * 64) = w; } }
    }
};
template <class Epi, class Sched, bool ALIGN_EPI = false, bool SP2 = false>
__device__ __forceinline__ void gemm_phase(PG8_LAS unsigned char* lds, const Gemm g, const Sched& S, const Epi& E) {
    int tid_ = threadIdx.x; asm volatile("" : "+v"(tid_));
    const int tid = tid_, wid = __builtin_amdgcn_readfirstlane(tid >> 6), lane = tid & 63, wr = wid >> 2, wc = wid & 3, fr = lane & 15, fq = lane >> 4;
    const int K = g.K;
    unsigned voffA[2], voffB[2];
#pragma unroll
    for (int i = 0; i < 2; ++i) { int R, C; stage_rc(tid * 16 + i * 8192, R, C); const int Rb = Epi::PERM ? ((R & ~31) + perm32(R & 31)) : R;
        voffA[i] = (unsigned)(R * g.lda + C) * 2u; voffB[i] = (unsigned)(Rb * K + C) * 2u; }
    const size_t kstep = (size_t)(BK * 2);
    const size_t hstepB = (size_t)HALF * K * 2, hstepA = (size_t)HALF * g.lda * 2;
    const size_t tstepB = 2 * hstepB, tstepA = 2 * hstepA;
    const unsigned ldsw = (unsigned)wid * 1024u;
    const int aoff = lds_byte(wr * 64 + fr, fq * 8), boff = lds_byte(wc * 32 + fr, fq * 8);
#define PG8_SA(b, h) (((b) * 2 + (h)) * HTB)
#define PG8_SB(b, h) ((4 + (b) * 2 + (h)) * HTB)
#define PG8_STAGE(bufoff, gbase, voff) do { _Pragma("unroll") for (int _i = 0; _i < 2; ++_i) \
        __builtin_amdgcn_global_load_lds((const unsigned*)((const char*)(gbase) + (voff)[_i]), (PG8_LAS unsigned*)(lds + (bufoff) + ldsw + _i * 8192), 16, 0, 0); } while (0)
#define PG8_LDA(dst, b, h) do { _Pragma("unroll") for (int m = 0; m < 4; ++m) _Pragma("unroll") for (int k = 0; k < 2; ++k) dst[m][k] = *(const PG8_LAS bf16x8*)(lds + PG8_SA(b, h) + aoff + m * 2048 + k * 1024); } while (0)
#define PG8_LDB(dst, b, h) do { _Pragma("unroll") for (int n = 0; n < 2; ++n) _Pragma("unroll") for (int k = 0; k < 2; ++k) dst[n][k] = *(const PG8_LAS bf16x8*)(lds + PG8_SB(b, h) + boff + n * 2048 + k * 1024); } while (0)
#define PG8_MMA(ai, bj, At, Bt) do { __builtin_amdgcn_s_setprio(1); _Pragma("unroll") for (int m = 0; m < 4; ++m) _Pragma("unroll") for (int n = 0; n < 2; ++n) _Pragma("unroll") for (int k = 0; k < 2; ++k) \
        acc[ai][bj][m][n] = __builtin_amdgcn_mfma_f32_16x16x32_bf16(Bt[n][k], At[m][k], acc[ai][bj][m][n], 0, 0, 0); __builtin_amdgcn_s_setprio(0); } while (0)
#define PG8_WAIT_V(n) asm volatile("s_waitcnt vmcnt(" #n ")" ::: "memory")
#define PG8_WAIT_L(n) asm volatile("s_waitcnt lgkmcnt(" #n ")" ::: "memory")
#define PG8_BAR __builtin_amdgcn_s_barrier()
#define PG8_SCHED __builtin_amdgcn_sched_barrier(0)
    Unit cur, nxt; int ui = 0;
    if (!S.next(0, cur)) return;
    f32x4 acc[2][2][4][2];
#pragma unroll
    for (int a = 0; a < 2; ++a)
#pragma unroll
        for (int b = 0; b < 2; ++b)
#pragma unroll
            for (int m = 0; m < 4; ++m)
#pragma unroll
                for (int n = 0; n < 2; ++n) acc[a][b][m][n] = (f32x4){0.f, 0.f, 0.f, 0.f};
    bf16x8 At[4][2], B0[2][2], B1[2][2];
    const char* cA = (const char*)g.A + (size_t)cur.pm * tstepA + (cur.aoff + cur.k0) * 2; const char* cB = (const char*)g.Bt + (size_t)cur.pn * tstepB + (size_t)cur.k0 * 2;
    S.a_ready(cur);
    if constexpr (SP2) {
        PG8_STAGE(PG8_SB(0, 0), cB, voffB); PG8_STAGE(PG8_SB(0, 1), cB + hstepB, voffB); PG8_STAGE(PG8_SA(0, 0), cA, voffA); PG8_STAGE(PG8_SA(0, 1), cA + hstepA, voffA);
        if (wr == 1) PG8_BAR;
        PG8_WAIT_V(2); PG8_BAR;
        PG8_STAGE(PG8_SB(1, 0), cB + kstep, voffB); PG8_STAGE(PG8_SA(1, 0), cA + kstep, voffA); PG8_STAGE(PG8_SB(1, 1), cB + hstepB + kstep, voffB);
        PG8_WAIT_V(6); PG8_BAR;
    } else {
        PG8_STAGE(PG8_SB(0, 0), cB, voffB); PG8_STAGE(PG8_SA(0, 0), cA, voffA); PG8_STAGE(PG8_SB(0, 1), cB + hstepB, voffB); PG8_STAGE(PG8_SA(0, 1), cA + hstepA, voffA);
        if (wr == 1) PG8_BAR;
        PG8_WAIT_V(4); PG8_BAR;
        PG8_STAGE(PG8_SB(1, 0), cB + kstep, voffB); PG8_STAGE(PG8_SA(1, 0), cA + kstep, voffA); PG8_STAGE(PG8_SB(1, 1), cB + hstepB + kstep, voffB);
        PG8_WAIT_V(6); PG8_BAR;
    }
    for (;;) {
        const bool has_next = S.next(ui + 1, nxt);
        const char* nA = has_next ? (const char*)g.A + (size_t)nxt.pm * tstepA + (nxt.aoff + nxt.k0) * 2 : cA; const char* nB = has_next ? (const char*)g.Bt + (size_t)nxt.pn * tstepB + (size_t)nxt.k0 * 2 : cB;
        const int nt = cur.nt;
        for (int t = 0; t < nt; t += 2) {
            const bool last = (t == nt - 2);
            const char* a1 = cA + (size_t)(t + 1) * kstep;
            const char* a2 = last ? nA : cA + (size_t)(t + 2) * kstep; const char* b2 = last ? nB : cB + (size_t)(t + 2) * kstep;
            const char* a3 = a2 + kstep; const char* b3 = b2 + kstep;
            if (last && has_next) S.a_ready(nxt);
            if constexpr (SP2) {
            PG8_LDB(B0, 0, 0); PG8_LDB(B1, 0, 1); PG8_SCHED; PG8_LDA(At, 0, 0); PG8_STAGE(PG8_SA(1, 1), a1 + hstepA, voffA);
            PG8_WAIT_V(8); PG8_WAIT_L(0); PG8_BAR; PG8_MMA(0, 0, At, B0); PG8_MMA(0, 1, At, B1); PG8_BAR; PG8_SCHED;
            PG8_LDA(At, 0, 1); PG8_STAGE(PG8_SB(0, 0), b2, voffB); PG8_STAGE(PG8_SB(0, 1), b2 + hstepB, voffB); PG8_STAGE(PG8_SA(0, 0), a2, voffA);
            PG8_WAIT_V(8); PG8_WAIT_L(0); PG8_BAR; PG8_MMA(1, 0, At, B0); PG8_MMA(1, 1, At, B1); PG8_BAR; PG8_SCHED;
            PG8_LDB(B0, 1, 0); PG8_LDB(B1, 1, 1); PG8_SCHED; PG8_LDA(At, 1, 0); PG8_STAGE(PG8_SA(0, 1), a2 + hstepA, voffA);
            PG8_WAIT_V(8); PG8_WAIT_L(0); PG8_BAR; PG8_MMA(0, 0, At, B0); PG8_MMA(0, 1, At, B1); PG8_BAR; PG8_SCHED;
            PG8_LDA(At, 1, 1); PG8_STAGE(PG8_SB(1, 0), b3, voffB); PG8_STAGE(PG8_SB(1, 1), b3 + hstepB, voffB); PG8_STAGE(PG8_SA(1, 0), a3, voffA);
            PG8_WAIT_V(8); PG8_WAIT_L(0); PG8_BAR; PG8_MMA(1, 0, At, B0); PG8_MMA(1, 1, At, B1); PG8_BAR; PG8_SCHED;
            } else {
            PG8_LDB(B0, 0, 0); PG8_SCHED; PG8_LDA(At, 0, 0); PG8_STAGE(PG8_SA(1, 1), a1 + hstepA, voffA);
            PG8_WAIT_L(8); PG8_BAR; PG8_WAIT_L(0); PG8_MMA(0, 0, At, B0); PG8_BAR; PG8_SCHED;
            PG8_LDB(B1, 0, 1); PG8_STAGE(PG8_SB(0, 0), b2, voffB);
            PG8_BAR; PG8_WAIT_L(0); PG8_MMA(0, 1, At, B1); PG8_BAR;
            PG8_LDA(At, 0, 1); PG8_STAGE(PG8_SA(0, 0), a2, voffA);
            PG8_BAR; PG8_WAIT_L(0); PG8_MMA(1, 0, At, B0); PG8_BAR; PG8_SCHED;
            PG8_STAGE(PG8_SB(0, 1), b2 + hstepB, voffB);
            PG8_WAIT_V(6); PG8_BAR; PG8_MMA(1, 1, At, B1); PG8_BAR;
            PG8_LDB(B0, 1, 0); PG8_SCHED; PG8_LDA(At, 1, 0); PG8_STAGE(PG8_SA(0, 1), a2 + hstepA, voffA);
            PG8_WAIT_L(8); PG8_BAR; PG8_WAIT_L(0); PG8_MMA(0, 0, At, B0); PG8_BAR; PG8_SCHED;
            PG8_LDB(B1, 1, 1); PG8_STAGE(PG8_SB(1, 0), b3, voffB);
            PG8_BAR; PG8_WAIT_L(0); PG8_MMA(0, 1, At, B1); PG8_BAR;
            PG8_LDA(At, 1, 1); PG8_STAGE(PG8_SA(1, 0), a3, voffA);
            PG8_BAR; PG8_WAIT_L(0); PG8_MMA(1, 0, At, B0); PG8_BAR; PG8_SCHED;
            PG8_STAGE(PG8_SB(1, 1), b3 + hstepB, voffB);
            PG8_WAIT_V(6); PG8_BAR; PG8_MMA(1, 1, At, B1); PG8_BAR;
            }
        }
        if constexpr (ALIGN_EPI) { if (wr == 0) PG8_BAR; }
        if constexpr (!Epi::AFTER_DRAIN) { E(acc, cur, wr, wc, fr, fq); S.done(cur); }
        if (!has_next) break;
#pragma unroll
        for (int a = 0; a < 2; ++a)
#pragma unroll
            for (int b = 0; b < 2; ++b)
#pragma unroll
                for (int m = 0; m < 4; ++m)
#pragma unroll
                    for (int n = 0; n < 2; ++n) acc[a][b][m][n] = (f32x4){0.f, 0.f, 0.f, 0.f};
        cur = nxt; cA = nA; cB = nB; ++ui;
        if constexpr (ALIGN_EPI) { if (wr == 1) PG8_BAR; }
    }
    PG8_WAIT_V(0);
    if constexpr (!ALIGN_EPI) { if (wr == 0) PG8_BAR; }
    PG8_BAR;
    if constexpr (Epi::AFTER_DRAIN) { E.fused(acc, cur, wr, wc, fr, fq, lds, wid, lane); S.done(cur); }
#undef PG8_SA
#undef PG8_SB
#undef PG8_STAGE
#undef PG8_LDA
#undef PG8_LDB
#undef PG8_MMA
#undef PG8_WAIT_V
#undef PG8_WAIT_L
#undef PG8_BAR
#undef PG8_SCHED
}
}

using pg8::bf16_t; using pg8::bf16x8; using pg8::f32x4; using pg8::u32x4; using pg8::u32x2; using pg8::cvt_pk_bf16; using pg8::fsigmoid;
#define LAS __attribute__((address_space(3)))
typedef float f32x16 __attribute__((ext_vector_type(16)));
typedef short s16x4 __attribute__((ext_vector_type(4)));
constexpr int D = 1024, NLAT = 16384, NCTX = 1024, MT = NLAT + NCTX, SEQ = 4096, CTXL = 256, DFF = 2816;
constexpr size_t MiB = 1u << 20;
constexpr size_t WS_MOD = 0, WS_H = 1 * MiB, WS_A = 69 * MiB, WS_B = 137 * MiB, WS_C = 239 * MiB, WS_ATTW = 345 * MiB, WS_S = 375 * MiB, WS_END = 384 * MiB;
constexpr size_t ACT = (size_t)MT * D;
constexpr int LDS_BYTES = 147456;
constexpr int NPH = 35;
enum { I_X = 0, I_C, I_CTX, I_CCTX, I_MODW, I_MODB, I_NMIX, I_NFFN, I_FW1, I_FW3, I_FW2, I_MU, I_WR, I_WK, I_WV, I_WO, I_W0, I_W1, I_W2, I_A0, I_A1, I_A2,
       I_G1, I_G2, I_KK, I_KA, I_RK, I_LNG, I_LNB, I_AWQ, I_AWK, I_AWV, I_AWO, I_AGQ, I_AGK, I_NWQKV, I_NWO, I_NGQ, I_NGK, I_RPB };
struct Params { const float* in[40]; float* out; unsigned char* ws; int ph_lo, ph_hi; };
#define CAS __attribute__((address_space(4)))
struct PV { int z; };
__device__ __forceinline__ const float* pin(int i, int z) { const CAS char* ka = (const CAS char*)__builtin_amdgcn_kernarg_segment_ptr(); return *(const float* const CAS*)(ka + 8 * i + z); }
#define PIN(i) pin((i), p.z)

__device__ __forceinline__ int opq(int x) { asm volatile("" : "+v"(x)); return x; }
__device__ __forceinline__ float bf2f(unsigned x) { return __uint_as_float(x << 16); }
__device__ __forceinline__ void unpack8(const u32x4 w, float* f) {
    f[0] = __uint_as_float(w.x << 16); f[1] = __uint_as_float(w.x & 0xffff0000u); f[2] = __uint_as_float(w.y << 16); f[3] = __uint_as_float(w.y & 0xffff0000u);
    f[4] = __uint_as_float(w.z << 16); f[5] = __uint_as_float(w.z & 0xffff0000u); f[6] = __uint_as_float(w.w << 16); f[7] = __uint_as_float(w.w & 0xffff0000u);
}
__device__ __forceinline__ f32x4 unpack4(const u32x2 w) {
    f32x4 r; r[0] = __uint_as_float(w.x << 16); r[1] = __uint_as_float(w.x & 0xffff0000u); r[2] = __uint_as_float(w.y << 16); r[3] = __uint_as_float(w.y & 0xffff0000u); return r;
}
__device__ __forceinline__ u32x4 pack8(const float* f) { u32x4 w; w.x = cvt_pk_bf16(f[0], f[1]); w.y = cvt_pk_bf16(f[2], f[3]); w.z = cvt_pk_bf16(f[4], f[5]); w.w = cvt_pk_bf16(f[6], f[7]); return w; }
template <int CTRL> __device__ __forceinline__ float dpp_add(float x) {
    return x + __builtin_bit_cast(float, __builtin_amdgcn_update_dpp(0, __builtin_bit_cast(int, x), CTRL, 0xF, 0xF, true));
}
__device__ __forceinline__ float red4(float x) { x = dpp_add<0xB1>(x); x = dpp_add<0x4E>(x); return x; }
__device__ __forceinline__ float red8(float x) { x = red4(x); x = dpp_add<0x141>(x); return x; }
__device__ __forceinline__ float red16(float x) { x = red8(x); x = dpp_add<0x140>(x); return x; }
__device__ __forceinline__ float wave_sum(float v) { v = red16(v); v += __shfl_xor(v, 16); v += __shfl_xor(v, 32); return v; }

struct CvtJob { const float* src; const float* scale; bf16_t* dst; int K, N, ld, col_off, row_off, mode; };
__device__ __forceinline__ void cvt_run(const CvtJob& J, int& gw, int ngw, int lane) {
    if (J.K <= 0) return;
    const int nb = J.N >> 6, nitems = (J.K >> 4) * nb;
    const int g0 = gw; { int r = (gw - nitems) % ngw; if (r < 0) r += ngw; gw = r; }
    for (int it = g0; it < nitems; it += ngw) {
        const int k0 = (it / nb) << 4, n = ((it % nb) << 6) + lane;
        float v[16];
#pragma unroll
        for (int i = 0; i < 16; ++i) { float x = 0.f; if (J.src) { x = J.src[(size_t)(k0 + i) * J.N + n]; if (J.scale) x *= J.scale[k0 + i]; } v[i] = x; }
        int dr = n; if (J.mode == 1) dr = ((n >> 2) << 3) + (n & 3); else if (J.mode == 2) dr = ((n >> 2) << 3) + 4 + (n & 3);
        bf16_t* dp = J.dst + (size_t)(J.row_off + dr) * J.ld + J.col_off + k0;
        *(u32x4*)dp = pack8(v); *(u32x4*)(dp + 8) = pack8(v + 8);
    }
}
__device__ __forceinline__ CvtJob mkjob(const float* src, const float* scale, bf16_t* dst, int K, int N, int ld, int col_off, int row_off, int mode) {
    CvtJob J; J.src = src; J.scale = scale; J.dst = dst; J.K = K; J.N = N; J.ld = ld; J.col_off = col_off; J.row_off = row_off; J.mode = mode; return J;
}
__device__ __forceinline__ void cvt_rwkv_mixer(const PV p, int j, bf16_t* W1b, bf16_t* W2b, bf16_t* Wo, int gw, int ngw, int lane) {
    const size_t DD = (size_t)D * D;
    cvt_run(mkjob(PIN(I_WR) + j * DD, nullptr, W1b, D, D, 1024, 0, 0, 0), gw, ngw, lane);
    cvt_run(mkjob(PIN(I_WK) + j * DD, nullptr, W1b, D, D, 1024, 0, 1024, 0), gw, ngw, lane);
    cvt_run(mkjob(PIN(I_WV) + j * DD, nullptr, W1b, D, D, 1024, 0, 2048, 0), gw, ngw, lane);
    for (int e = 0; e < 2; ++e) {
        cvt_run(mkjob(PIN(I_W1) + ((size_t)j * 2 + e) * D * 64, nullptr, W1b, D, 64, 1024, 0, 3072 + 64 * e, 0), gw, ngw, lane);
        cvt_run(mkjob(PIN(I_A1) + ((size_t)j * 2 + e) * D * 64, nullptr, W1b, D, 64, 1024, 0, 3328 + 64 * e, 0), gw, ngw, lane);
    }
    cvt_run(mkjob(PIN(I_G1) + (size_t)j * D * 128, nullptr, W1b, D, 128, 1024, 0, 3584, 0), gw, ngw, lane);
    cvt_run(mkjob(nullptr, nullptr, W1b, D, 128, 1024, 0, 3200, 0), gw, ngw, lane);
    cvt_run(mkjob(nullptr, nullptr, W1b, D, 128, 1024, 0, 3456, 0), gw, ngw, lane);
    cvt_run(mkjob(nullptr, nullptr, W1b, D, 128, 1024, 0, 3712, 0), gw, ngw, lane);
    for (int rg = 0; rg < 5; ++rg) {
        const int c0 = rg < 4 ? 64 * rg : 256, kw = rg < 4 ? 64 : 128;
        const float* src = rg == 0 ? PIN(I_W2) + ((size_t)j * 2 + 0) * 64 * D : rg == 1 ? PIN(I_W2) + ((size_t)j * 2 + 1) * 64 * D
                         : rg == 2 ? PIN(I_A2) + ((size_t)j * 2 + 0) * 64 * D : rg == 3 ? PIN(I_A2) + ((size_t)j * 2 + 1) * 64 * D : PIN(I_G2) + (size_t)j * 128 * D;
        cvt_run(mkjob(src, nullptr, W2b, kw, D, 384, c0, rg * 1024, 0), gw, ngw, lane);
        cvt_run(mkjob(nullptr, nullptr, W2b, c0, D, 384, 0, rg * 1024, 0), gw, ngw, lane);
        cvt_run(mkjob(nullptr, nullptr, W2b, 384 - c0 - kw, D, 384, c0 + kw, rg * 1024, 0), gw, ngw, lane);
    }
    cvt_run(mkjob(PIN(I_WO) + j * DD, nullptr, Wo, D, D, 1024, 0, 0, 0), gw, ngw, lane);
}
__device__ __forceinline__ void cvt_ffn(const PV p, int L, bf16_t* W13, bf16_t* W2t, int gw, int ngw, int lane) {
    const size_t FW = (size_t)D * DFF;
    cvt_run(mkjob(PIN(I_FW1) + L * FW, nullptr, W13, D, DFF, 1024, 0, 0, 1), gw, ngw, lane);
    cvt_run(mkjob(PIN(I_FW3) + L * FW, nullptr, W13, D, DFF, 1024, 0, 0, 2), gw, ngw, lane);
    cvt_run(mkjob(PIN(I_FW2) + L * FW, nullptr, W2t, DFF, D, DFF, 0, 0, 0), gw, ngw, lane);
}

__device__ __forceinline__ void phase_mod(const PV p, LAS float* sc  , float* MOD) {
    const int tid = opq((int)threadIdx.x);
    for (int i = tid; i < 5 * D; i += 512) { const float c = i < 4 * D ? PIN(I_C)[i] : PIN(I_CCTX)[i - 4 * D]; sc[i] = c / (1.0f + __expf(-c)); }
    __syncthreads();
    LAS float* red = sc + 5 * D;
    for (int it = blockIdx.x; it < 384; it += gridDim.x) {
        const int l = it / 96, e0 = (it % 96) * 64, el = tid & 63, dq = tid >> 6;
        const float* w = PIN(I_MODW) + ((size_t)l * D + dq * 128) * 6144 + e0 + el;
        float a0 = 0.f, a1 = 0.f, a2 = 0.f, a3 = 0.f, a4 = 0.f;
#pragma unroll 16
        for (int d = 0; d < 128; ++d) { const float x = w[(size_t)d * 6144]; const int dd = dq * 128 + d;
            a0 += sc[dd] * x; a1 += sc[D + dd] * x; a2 += sc[2 * D + dd] * x; a3 += sc[3 * D + dd] * x; a4 += sc[4 * D + dd] * x; }
        LAS float* rp = red + (dq * 64 + el) * 5; rp[0] = a0; rp[1] = a1; rp[2] = a2; rp[3] = a3; rp[4] = a4;
        __syncthreads();
        if (tid < 320) { const int e = tid & 63, jj = tid >> 6; float s = 0.f;
#pragma unroll
            for (int q = 0; q < 8; ++q) s += red[(q * 64 + e) * 5 + jj];
            MOD[((size_t)l * 5 + jj) * 6144 + e0 + e] = s + PIN(I_MODB)[l * 6144 + e0 + e]; }
        __syncthreads();
    }
}

__device__ __forceinline__ void norm_row(const float* hrow, const float* g, const float* scv, const float* shv, int lane, f32x4 (&a)[4], const float* prow = nullptr, int nsplit = 0, float* wb = nullptr) {
    f32x4 v[4]; float ss = 0.f;
#pragma unroll
    for (int j = 0; j < 4; ++j) { v[j] = *(const f32x4*)(hrow + 4 * lane + 256 * j);
        if (nsplit) { f32x4 pp[11];
#pragma unroll
            for (int s_ = 0; s_ < 11; ++s_) pp[s_] = (s_ < nsplit) ? *(const f32x4*)(prow + (size_t)s_ * 1048576 + 4 * lane + 256 * j) : (f32x4){0.f, 0.f, 0.f, 0.f};
#pragma unroll
            for (int s_ = 0; s_ < 11; ++s_) v[j] += pp[s_];
            *(f32x4*)(wb + 4 * lane + 256 * j) = v[j]; } ss += (v[j][0] * v[j][0] + v[j][1] * v[j][1]) + (v[j][2] * v[j][2] + v[j][3] * v[j][3]); }
    const float rstd = rsqrtf(wave_sum(ss) * (1.0f / D) + 1e-6f);
#pragma unroll
    for (int j = 0; j < 4; ++j) { const int c = 4 * lane + 256 * j; const f32x4 gg = *(const f32x4*)(g + c), s1 = *(const f32x4*)(scv + c), s0 = *(const f32x4*)(shv + c);
        a[j] = v[j] * rstd * gg * (1.0f + s1) + s0; }
}
__device__ __forceinline__ void phase_norm(const float* base_lat, const float* base_ctx, const float* g, const float* modl  , int off_sh, int off_sc,
                                           bf16_t* out, int M, int gw, int ngw, int lane, float* Hw = nullptr, const float* part = nullptr, int nsplit = 0) {
    for (int row = gw; row < NLAT; row += 2 * ngw) {
        const int row2 = row + ngw; const bool has2 = row2 < NLAT; const int r2 = has2 ? row2 : row;
        const float* mv = modl + (row >> 12) * 6144; const float* mv2 = modl + (r2 >> 12) * 6144;
        const float* h1 = base_lat + (size_t)row * D; const float* h2 = base_lat + (size_t)r2 * D;
        f32x4 v1[4], v2[4]; float s1 = 0.f, s2 = 0.f;
#pragma unroll
        for (int j = 0; j < 4; ++j) { v1[j] = *(const f32x4*)(h1 + 4 * lane + 256 * j); v2[j] = *(const f32x4*)(h2 + 4 * lane + 256 * j); }
#pragma unroll
        for (int j = 0; j < 4; ++j) { s1 += (v1[j][0] * v1[j][0] + v1[j][1] * v1[j][1]) + (v1[j][2] * v1[j][2] + v1[j][3] * v1[j][3]); s2 += (v2[j][0] * v2[j][0] + v2[j][1] * v2[j][1]) + (v2[j][2] * v2[j][2] + v2[j][3] * v2[j][3]); }
        const float rs1 = rsqrtf(wave_sum(s1) * (1.0f / D) + 1e-6f), rs2 = rsqrtf(wave_sum(s2) * (1.0f / D) + 1e-6f);
#pragma unroll
        for (int j = 0; j < 4; ++j) { const int c = 4 * lane + 256 * j; const f32x4 gg = *(const f32x4*)(g + c);
            { const f32x4 sc = *(const f32x4*)(mv + off_sc + c), sh = *(const f32x4*)(mv + off_sh + c); const f32x4 a = v1[j] * rs1 * gg * (1.0f + sc) + sh;
              u32x2 w; w.x = cvt_pk_bf16(a[0], a[1]); w.y = cvt_pk_bf16(a[2], a[3]); *(u32x2*)(out + (size_t)row * D + c) = w; }
            if (has2) { const f32x4 sc = *(const f32x4*)(mv2 + off_sc + c), sh = *(const f32x4*)(mv2 + off_sh + c); const f32x4 a = v2[j] * rs2 * gg * (1.0f + sc) + sh;
              u32x2 w; w.x = cvt_pk_bf16(a[0], a[1]); w.y = cvt_pk_bf16(a[2], a[3]); *(u32x2*)(out + (size_t)row2 * D + c) = w; } }
    }
    for (int row = NLAT + gw; row < M; row += ngw) {
        const float* mv = modl + 4 * 6144;
        f32x4 a[4];
        if (nsplit) norm_row(base_ctx + (size_t)row * D, g, mv + off_sc, mv + off_sh, lane, a, part + (size_t)(row - NLAT) * D, nsplit, Hw + (size_t)row * D);
        else norm_row(base_ctx + (size_t)row * D, g, mv + off_sc, mv + off_sh, lane, a);
#pragma unroll
        for (int j = 0; j < 4; ++j) { u32x2 w; w.x = cvt_pk_bf16(a[j][0], a[j][1]); w.y = cvt_pk_bf16(a[j][2], a[j][3]); *(u32x2*)(out + (size_t)row * D + 4 * lane + 256 * j) = w; }
    }
}
__device__ __forceinline__ void load_row4(const float* __restrict__ hrow, int lane, f32x4 (&v)[4]) {
#pragma unroll
    for (int j = 0; j < 4; ++j) v[j] = *(const f32x4*)(hrow + 4 * lane + 256 * j);
}
__device__ __forceinline__ void norm_finish(f32x4 (&v)[4], const float* __restrict__ g, const float* __restrict__ scv, const float* __restrict__ shv, int lane) {
    float ss = 0.f;
#pragma unroll
    for (int j = 0; j < 4; ++j) ss += (v[j][0] * v[j][0] + v[j][1] * v[j][1]) + (v[j][2] * v[j][2] + v[j][3] * v[j][3]);
    const float rstd = rsqrtf(wave_sum(ss) * (1.0f / D) + 1e-6f);
#pragma unroll
    for (int j = 0; j < 4; ++j) { const int c = 4 * lane + 256 * j; const f32x4 gg = *(const f32x4*)(g + c), s1 = *(const f32x4*)(scv + c), s0 = *(const f32x4*)(shv + c);
        v[j] = v[j] * rstd * gg * (1.0f + s1) + s0; }
}
__device__ __forceinline__ void phase_norm_shift(const float* __restrict__ base_lat, const float* __restrict__ base_ctx, const float* __restrict__ g, const float* __restrict__ modl, const float* __restrict__ mu,
                                                 bf16_t* __restrict__ XA, bf16_t* __restrict__ XC, int gw, int ngw, int lane) {
    for (int pi = gw; pi < MT / 2; pi += ngw) {
        const int row = 2 * pi; const bool lat = row < NLAT; const int bidx = lat ? row >> 12 : 4; const float* hb = lat ? base_lat : base_ctx; const float* mv = modl + bidx * 6144;
        const int t = lat ? (row & 4095) : ((row - NLAT) & 255), len = lat ? SEQ : CTXL; const bool hasp = t > 0, hasn = t + 2 < len;
        f32x4 a0[4], a1[4], ap[4], an[4];
        load_row4(hb + (size_t)row * D, lane, a0); load_row4(hb + (size_t)(row + 1) * D, lane, a1);
        load_row4(hb + (size_t)(hasp ? row - 1 : row) * D, lane, ap); load_row4(hb + (size_t)(hasn ? row + 2 : row) * D, lane, an);
        norm_finish(a0, g, mv + 1024, mv, lane); norm_finish(a1, g, mv + 1024, mv, lane); norm_finish(ap, g, mv + 1024, mv, lane); norm_finish(an, g, mv + 1024, mv, lane);
        const float fp = hasp ? 0.5f : 0.f, fn = hasn ? 0.5f : 0.f;
#pragma unroll
        for (int j = 0; j < 4; ++j) { const f32x4 xx0 = fp * ap[j] + 0.5f * a1[j] - a0[j], xx1 = 0.5f * a0[j] + fn * an[j] - a1[j]; const int c = 4 * lane + 256 * j; const size_t e0 = (size_t)row * D + c;
#pragma unroll
            for (int i = 0; i < 6; ++i) {
                const f32x4 m_ = *(const f32x4*)(mu + i * D + c); const f32x4 x0 = a0[j] + xx0 * m_, x1 = a1[j] + xx1 * m_;
                bf16_t* dst = (i == 0) ? XC : (i == 1) ? XC + 3 * ACT : (i == 2) ? XC + ACT : (i == 3) ? XC + 2 * ACT : (i == 4) ? XA : XA + ACT;
                u32x2 w0; w0.x = cvt_pk_bf16(x0[0], x0[1]); w0.y = cvt_pk_bf16(x0[2], x0[3]); *(u32x2*)(dst + e0) = w0;
                u32x2 w1; w1.x = cvt_pk_bf16(x1[0], x1[1]); w1.y = cvt_pk_bf16(x1[2], x1[3]); *(u32x2*)(dst + e0 + D) = w1; } }
    }
}

__device__ __forceinline__ int scan_row(int ci, int tt, int dir, int b) {
    if (ci < 8) { const int s = ci * 32 + tt; return NLAT + b * CTXL + (dir ? CTXL - 1 - s : s); }
    const int s = (ci - 8) * 32 + tt; return b * SEQ + (dir ? SEQ - 1 - s : s);
}
#ifndef SCAN_PROBE
#define SCAN_PROBE 0
#endif
typedef float f32x2 __attribute__((ext_vector_type(2)));
struct ScanRaw { u32x2 r, k, v, lw, la; };
__device__ __forceinline__ ScanRaw scan_load(const bf16_t* R, const bf16_t* LWd, unsigned eb) {
    const char* Rb = (const char*)R; const char* Lb = (const char*)LWd; ScanRaw x;
    x.r = *(const u32x2*)(Rb + eb); x.k = *(const u32x2*)(Rb + (eb + (unsigned)(ACT * 2))); x.v = *(const u32x2*)(Rb + (eb + (unsigned)(ACT * 4)));
    x.lw = *(const u32x2*)(Lb + eb); x.la = *(const u32x2*)(Lb + (eb + (unsigned)(ACT * 4))); return x;
}
__device__ __forceinline__ int scan_row16(int ci, int t, int dir, int b) {
    if (ci < 16) { const int s = ci * 16 + t; return NLAT + b * CTXL + (dir ? CTXL - 1 - s : s); }
    const int s = (ci - 16) * 16 + t; return b * SEQ + (dir ? SEQ - 1 - s : s);
}
__device__ __forceinline__ bf16x8 ldfrag(const LAS unsigned char* base, int stride, int row, int kbyte) { return *(const LAS bf16x8*)(base + row * stride + kbyte); }
__device__ __forceinline__ unsigned short f2bf1(float x) { unsigned u = __float_as_uint(x); u += 0x7fffu + ((u >> 16) & 1u); return (unsigned short)(u >> 16); }
#define MFMA16(a, b, c) __builtin_amdgcn_mfma_f32_16x16x32_bf16((a), (b), (c), 0, 0, 0)
__device__ __forceinline__ void phase_scan(const PV p, int j, LAS unsigned char* lds, const bf16_t* R, const bf16_t* K, const bf16_t* V, const bf16_t* LW, const bf16_t* LA,
                                           bf16_t* Y, float* COEF) {
    const int tid = opq((int)threadIdx.x), lane = tid & 63, w = __builtin_amdgcn_readfirstlane(tid >> 6), l15 = lane & 15, quad = lane >> 4;
    constexpr int SA = 144, SB = 80;
    constexpr int O_AB = 0, O_RB = 2304, O_VT = 4608, O_BTT = 9728, O_KTT = 14848, O_PC = 19968, RINGSZ = 20224;
    constexpr int O_NQ = 4 * RINGSZ, O_NKAT = 0, O_QBRT = 1280, O_QKRT = 2560, O_TT = 3840, NQSZ = 5120;
    constexpr int O_BK = O_NQ + 2 * NQSZ, O_BB = 0, O_KB = 2304, BKSZ = 4608;
    constexpr int O_LW = O_BK + 2 * BKSZ, O_NBA = O_LW + 4096, O_PRIV = O_NBA + 1024, PRIVSZ = 4864, O_YB = O_PRIV + 4 * PRIVSZ, O_TS = O_YB + 2 * 2048, O_END = O_TS + 3840;
    constexpr int NCH = 272;
#define SC_BAR() do { asm volatile("s_waitcnt lgkmcnt(0)" ::: "memory"); __builtin_amdgcn_s_barrier(); asm volatile("" ::: "memory"); } while (0)
    for (int u = blockIdx.x; u < 256; u += gridDim.x) {
        const int half = u & 1, dir = (u >> 1) & 1, h = (u >> 2) & 15, b = u >> 6;
        __syncthreads();
        for (int i = tid; i < O_END / 16; i += 512) ((LAS u32x4*)lds)[i] = (u32x4){0u, 0u, 0u, 0u};
        __syncthreads();
        bf16_t* Yd = Y + (size_t)dir * ACT;
        if (w == 2 || w == 3 || w == 6 || w == 7) {
            const int hw = (w & 1) | ((w >> 2) << 1), t = hw * 4 + (lane >> 4), nq = lane & 15, ncol = h * 64 + 4 * nq;
            const f32x4 kkc = *(const f32x4*)(PIN(I_KK) + j * D + ncol), kac = *(const f32x4*)(PIN(I_KA) + j * D + ncol), rkc = *(const f32x4*)(PIN(I_RK) + j * D + ncol);
            const f32x4 w0c = *(const f32x4*)(PIN(I_W0) + (j * 2 + dir) * D + ncol), a0c = *(const f32x4*)(PIN(I_A0) + (j * 2 + dir) * D + ncol);
            const bf16_t* LWd = LW + (size_t)dir * ACT; float* Cd = COEF + (size_t)dir * MT * 16;
            ScanRaw ra = scan_load(R, LWd, (unsigned)(scan_row16(0, t, dir, b) * D + ncol) * 2u);
            f32x4 al4, be4, kd4, r4, lw4, cw4, iw4;
            const float fh0 = hw > 0 ? 1.f : 0.f, fh1 = hw > 1 ? 1.f : 0.f, fh2 = hw > 2 ? 1.f : 0.f, m16_ = lane >= 16 ? 1.f : 0.f, m32_ = lane >= 32 ? 1.f : 0.f;
            for (int c = -3; c <= NCH; ++c) {
                const int n = c + 2, n0 = c + 3; const bool act1 = n >= 0 && n < NCH, act0 = n0 < NCH;
                LAS unsigned char* rg = lds + ((n + 4) & 3) * RINGSZ; LAS unsigned char* bk = lds + O_BK + (n & 1) * BKSZ; LAS unsigned char* rg0 = lds + (n0 & 3) * RINGSZ;
                LAS unsigned char* wt1 = lds + O_LW + (n & 1) * 1024; LAS unsigned char* wt0w = lds + O_LW + (n0 & 1) * 1024;
                if (act1) {
#if SCAN_PROBE == 3
                    for (int rep_ = 0; rep_ < 2; ++rep_) { asm volatile("" ::: "memory");
#endif
                    const f32x4 wt0 = *(const LAS f32x4*)(wt1 + (0 * 64 + 4 * nq) * 4), wt1v = *(const LAS f32x4*)(wt1 + (1 * 64 + 4 * nq) * 4),
                                wt2 = *(const LAS f32x4*)(wt1 + (2 * 64 + 4 * nq) * 4), wt3 = *(const LAS f32x4*)(wt1 + (3 * 64 + 4 * nq) * 4);
                    const f32x4 z4_ = {0.f, 0.f, 0.f, 0.f};
                    const f32x4 cum = ((cw4 + wt0 * fh0) + wt1v * fh1) + wt2 * fh2, tot = (wt0 + wt1v) + (wt2 + wt3);
                    f32x4 ab, bb, kb, rb, bt, kt, pc;
#pragma unroll
                    for (int i = 0; i < 4; ++i) { const float pt = __builtin_amdgcn_exp2f(cum[i]), ip = __builtin_amdgcn_rcpf(pt), pp = pt * iw4[i], cp = __builtin_amdgcn_exp2f(tot[i] - cum[i]); pc[i] = pt;
                        ab[i] = al4[i] * pp; bb[i] = be4[i] * ip; kb[i] = kd4[i] * ip; rb[i] = r4[i] * pt; bt[i] = be4[i] * cp; kt[i] = kd4[i] * cp; }
                    u32x2 q; q.x = cvt_pk_bf16(ab[0], ab[1]); q.y = cvt_pk_bf16(ab[2], ab[3]); *(LAS u32x2*)(rg + O_AB + t * SA + nq * 8) = q;
                    q.x = cvt_pk_bf16(rb[0], rb[1]); q.y = cvt_pk_bf16(rb[2], rb[3]); *(LAS u32x2*)(rg + O_RB + t * SA + nq * 8) = q;
                    q.x = cvt_pk_bf16(bb[0], bb[1]); q.y = cvt_pk_bf16(bb[2], bb[3]); *(LAS u32x2*)(bk + O_BB + t * SA + nq * 8) = q;
                    q.x = cvt_pk_bf16(kb[0], kb[1]); q.y = cvt_pk_bf16(kb[2], kb[3]); *(LAS u32x2*)(bk + O_KB + t * SA + nq * 8) = q;
#pragma unroll
                    for (int i = 0; i < 4; ++i) { *(LAS unsigned short*)(rg + O_BTT + (i * 16 + nq) * SB + t * 2) = f2bf1(bt[i]); *(LAS unsigned short*)(rg + O_KTT + (i * 16 + nq) * SB + t * 2) = f2bf1(kt[i]); }
                    if (t == 15) *(LAS f32x4*)(rg + O_PC + 16 * nq) = pc;
#if SCAN_PROBE == 3
                    }
#endif
                }
                if (act0) {
#if SCAN_PROBE == 2
                    for (int rep_ = 0; rep_ < 2; ++rep_) { asm volatile("" ::: "memory");
#endif
                    r4 = unpack4(ra.r); const f32x4 k4 = unpack4(ra.k), v4 = unpack4(ra.v), lwl = unpack4(ra.lw), la4 = unpack4(ra.la);
                    const f32x4 kkr = k4 * kkc; float ss_ = (kkr[0] * kkr[0] + kkr[1] * kkr[1]) + (kkr[2] * kkr[2] + kkr[3] * kkr[3]); ss_ = red16(ss_);
                    const float inv = __builtin_amdgcn_rcpf(fmaxf(__builtin_amdgcn_sqrtf(ss_), 1e-12f)); const f32x4 kk4 = kkr * inv; f32x4 a4;
#pragma unroll
                    for (int i = 0; i < 4; ++i) { lw4[i] = (-0.6065306597126334f * 1.4426950408889634f) * fsigmoid(w0c[i] + lwl[i]); iw4[i] = __builtin_amdgcn_exp2f(-lw4[i]); a4[i] = fsigmoid(a0c[i] + la4[i]); }
                    kd4 = k4 * (1.0f + (a4 - 1.0f) * kac); be4 = kk4 * a4; al4 = -kk4;
                    if (half == 0) { const f32x4 rq = r4 * kd4 * rkc; float cf = (rq[0] + rq[1]) + (rq[2] + rq[3]); cf = red16(cf);
                        if (nq == 0) Cd[(size_t)scan_row16(n0, t, dir, b) * 16 + h] = cf; }
                    cw4 = lw4;
#pragma unroll
                    for (int i = 0; i < 4; ++i) { float y_ = __shfl_up(cw4[i], 16); cw4[i] = fmaf(y_, m16_, cw4[i]); y_ = __shfl_up(cw4[i], 32); cw4[i] = fmaf(y_, m32_, cw4[i]); }
                    if (lane >= 48) *(LAS f32x4*)(wt0w + (hw * 64 + 4 * nq) * 4) = cw4;
#pragma unroll
                    for (int i = 0; i < 4; ++i) *(LAS unsigned short*)(rg0 + O_VT + (i * 16 + nq) * SB + t * 2) = f2bf1(v4[i]);
#if SCAN_PROBE == 2
                    }
#endif
                    if (n0 + 1 < NCH) ra = scan_load(R, LWd, (unsigned)(scan_row16(n0 + 1, t, dir, b) * D + ncol) * 2u);
                }
                SC_BAR();
            }
        } else {
            const int cw = (w >= 4) ? (w - 4) : (w + 2), vrow0 = 32 * half + 16 * (cw & 1);
            LAS unsigned char* Sb = lds + O_PRIV + cw * PRIVSZ; LAS unsigned char* W2b = Sb + 2304; LAS unsigned char* Ub = W2b + 1280;
            f32x4 St0 = {0.f, 0.f, 0.f, 0.f}, St1 = St0, St2 = St0, St3 = St0;
            float one_ = 1.0f; asm volatile("" : "+v"(one_)); const f32x2 o2_ = {one_, one_};
#define SC_PK2(a_, b_) ({ const f32x2 t_ = (f32x2){(a_), (b_)} * o2_; cvt_pk_bf16(t_[0], t_[1]); })
#define SC_FENCE() asm volatile("s_waitcnt lgkmcnt(0)" ::: "memory")
            for (int c = -3; c <= NCH; ++c) {
                if (c >= 0 && c < NCH && cw < 2) {
                    const LAS unsigned char* rg = lds + (c & 3) * RINGSZ; const LAS unsigned char* nqb = lds + O_NQ + (c & 1) * NQSZ;
                    const int k0b = (8 * quad) * 2, k1b = (32 + 8 * quad) * 2, kq = 16 * quad;
                    const bf16x8 sb0 = ldfrag(Sb, SA, l15, k0b), sb1 = ldfrag(Sb, SA, l15, k1b);
                    const bf16x8 ab0 = ldfrag(rg + O_AB, SA, l15, k0b), ab1 = ldfrag(rg + O_AB, SA, l15, k1b), rb0 = ldfrag(rg + O_RB, SA, l15, k0b), rb1 = ldfrag(rg + O_RB, SA, l15, k1b);
                    const bf16x8 va = ldfrag(rg + O_VT, SB, ((vrow0 + l15) & 3) * 16 + ((vrow0 + l15) >> 2), kq);
                    const bf16x8 nka = ldfrag(nqb + O_NKAT, SB, l15, kq), ttf = ldfrag(nqb + O_TT, SB, l15, kq), qbr = ldfrag(nqb + O_QBRT, SB, l15, kq), qkr = ldfrag(nqb + O_QKRT, SB, l15, kq);
                    const bf16x8 bt0 = ldfrag(rg + O_BTT, SB, l15, kq), bt1 = ldfrag(rg + O_BTT, SB, 16 + l15, kq), bt2 = ldfrag(rg + O_BTT, SB, 32 + l15, kq), bt3 = ldfrag(rg + O_BTT, SB, 48 + l15, kq);
                    const bf16x8 kt0 = ldfrag(rg + O_KTT, SB, l15, kq), kt1 = ldfrag(rg + O_KTT, SB, 16 + l15, kq), kt2 = ldfrag(rg + O_KTT, SB, 32 + l15, kq), kt3 = ldfrag(rg + O_KTT, SB, 48 + l15, kq);
                    const f32x4 pcv = *(const LAS f32x4*)(rg + O_PC + 16 * l15); const float pc0 = pcv[0], pc1 = pcv[1], pc2 = pcv[2], pc3 = pcv[3];
                    SC_FENCE();
                    const f32x4 z4 = {0.f, 0.f, 0.f, 0.f};
                    f32x4 acc = MFMA16(sb0, ab0, z4); acc = MFMA16(sb1, ab1, acc); acc = MFMA16(va, nka, acc);
                    f32x4 accY = MFMA16(rb0, sb0, z4); accY = MFMA16(rb1, sb1, accY); accY = MFMA16(qkr, va, accY);
                    St0 = St0 * pc0; St1 = St1 * pc1; St2 = St2 * pc2; St3 = St3 * pc3;
                    St0 = MFMA16(va, kt0, St0); St1 = MFMA16(va, kt1, St1); St2 = MFMA16(va, kt2, St2); St3 = MFMA16(va, kt3, St3);
#pragma unroll
                    for (int jj = 0; jj < 4; jj += 2) { const unsigned pk_ = SC_PK2(acc[jj], acc[jj + 1]); *(LAS unsigned short*)(W2b + (quad * 4 + jj) * SB + l15 * 2) = (unsigned short)(pk_ & 0xffffu); *(LAS unsigned short*)(W2b + (quad * 4 + jj + 1) * SB + l15 * 2) = (unsigned short)(pk_ >> 16); }
                    SC_FENCE();
                    const bf16x8 w2f = ldfrag(W2b, SB, l15, kq);
                    SC_FENCE();
                    acc = MFMA16(w2f, ttf, z4);
#pragma unroll
                    for (int jj = 0; jj < 4; jj += 2) { const unsigned pk_ = SC_PK2(acc[jj], acc[jj + 1]); *(LAS unsigned short*)(Ub + (quad * 4 + jj) * SB + l15 * 2) = (unsigned short)(pk_ & 0xffffu); *(LAS unsigned short*)(Ub + (quad * 4 + jj + 1) * SB + l15 * 2) = (unsigned short)(pk_ >> 16); }
                    SC_FENCE();
                    const bf16x8 ua = ldfrag(Ub, SB, l15, kq);
                    SC_FENCE();
                    accY = MFMA16(qbr, ua, accY);
                    St0 = MFMA16(ua, bt0, St0); St1 = MFMA16(ua, bt1, St1); St2 = MFMA16(ua, bt2, St2); St3 = MFMA16(ua, bt3, St3);
#pragma unroll
                    for (int jj = 0; jj < 4; jj += 2) { const unsigned pk_ = SC_PK2(accY[jj], accY[jj + 1]); *(LAS unsigned short*)(lds + O_YB + (c & 1) * 2048 + (quad * 4 + jj) * 128 + (vrow0 + l15) * 2) = (unsigned short)(pk_ & 0xffffu); *(LAS unsigned short*)(lds + O_YB + (c & 1) * 2048 + (quad * 4 + jj + 1) * 128 + (vrow0 + l15) * 2) = (unsigned short)(pk_ >> 16); }
#pragma unroll
                    for (int jj = 0; jj < 4; ++jj) { u32x2 sq;
                        sq.x = SC_PK2(St0[jj], St1[jj]); sq.y = SC_PK2(St2[jj], St3[jj]);
                        *(LAS u32x2*)(Sb + (quad * 4 + jj) * SA + 8 * l15) = sq; }
                }
                if (cw == 3 && c >= 1) {
                    const int ts_ = lane >> 2, g8_ = lane & 3; const u32x4 yv = *(const LAS u32x4*)(lds + O_YB + ((c - 1) & 1) * 2048 + ts_ * 128 + half * 64 + g8_ * 16);
                    *(u32x4*)(Yd + (size_t)scan_row16(c - 1, ts_, dir, b) * D + h * 64 + half * 32 + g8_ * 8) = yv; }
                const int n = c + 1;
                if (n >= 0 && n < NCH) {
                    const int pidx = (cw == 0) ? 2 : (cw == 2) ? 0 : cw;
                    const LAS unsigned char* rg = lds + (n & 3) * RINGSZ; const LAS unsigned char* bk = lds + O_BK + (n & 1) * BKSZ; LAS unsigned char* nqb = lds + O_NQ + (n & 1) * NQSZ;
                    const LAS unsigned char* X = bk + ((pidx & 1) ? O_KB : O_BB); const LAS unsigned char* Yv = rg + ((pidx & 2) ? O_RB : O_AB);
                    f32x4 acc = {0.f, 0.f, 0.f, 0.f};
#pragma unroll
                    for (int ks = 0; ks < 2; ++ks) acc = MFMA16(ldfrag(X, SA, l15, (32 * ks + 8 * quad) * 2), ldfrag(Yv, SA, l15, (32 * ks + 8 * quad) * 2), acc);
                    const int ii = opq(l15);
                    f32x4 nm;
#pragma unroll
                    for (int jj = 0; jj < 4; ++jj) { const int mm = quad * 4 + jj; const bool keep = (pidx & 2) ? (mm <= ii) : (mm < ii); nm[jj] = keep ? acc[jj] : 0.f; }
                    if (pidx != 0) {
#pragma unroll
                        for (int jj = 0; jj < 4; jj += 2) *(LAS unsigned*)(nqb + (pidx == 1 ? O_NKAT : pidx == 2 ? O_QBRT : O_QKRT) + ii * SB + (quad * 4 + jj) * 2) = SC_PK2(nm[jj], nm[jj + 1]);
                    } else {
                        LAS unsigned char* TP = lds + O_TS; LAS unsigned char* TPT = TP + 1280; LAS unsigned char* TXT = TPT + 1280;
                        f32x4 Xs, Pc = nm;
#pragma unroll
                        for (int jj = 0; jj < 4; ++jj) Xs[jj] = nm[jj] + ((quad * 4 + jj) == ii ? 1.f : 0.f);
#pragma unroll
                        for (int lv = 0; lv < 4; ++lv) {
#pragma unroll
                            for (int jj = 0; jj < 4; jj += 2) { const int mm = quad * 4 + jj; const unsigned pp_ = SC_PK2(Pc[jj], Pc[jj + 1]);
                                *(LAS unsigned short*)(TP + mm * SB + ii * 2) = (unsigned short)(pp_ & 0xffffu); *(LAS unsigned short*)(TP + (mm + 1) * SB + ii * 2) = (unsigned short)(pp_ >> 16);
                                if (lv < 3) *(LAS unsigned*)(TPT + ii * SB + mm * 2) = pp_;
                                if (lv > 0) *(LAS unsigned*)(TXT + ii * SB + mm * 2) = SC_PK2(Xs[jj], Xs[jj + 1]); }
                            SC_FENCE();
                            const bf16x8 pa_ = ldfrag(TP, SB, l15, 16 * quad);
                            if (lv > 0) { const bf16x8 xb_ = ldfrag(TXT, SB, l15, 16 * quad); SC_FENCE(); Xs = MFMA16(pa_, xb_, Xs); }
                            if (lv < 3) { const bf16x8 pb_ = ldfrag(TPT, SB, l15, 16 * quad); SC_FENCE(); const f32x4 z4_ = {0.f, 0.f, 0.f, 0.f}; Pc = MFMA16(pa_, pb_, z4_); }
                            SC_FENCE();
                        }
#pragma unroll
                        for (int jj = 0; jj < 4; jj += 2) *(LAS unsigned*)(nqb + O_TT + ii * SB + (quad * 4 + jj) * 2) = SC_PK2(Xs[jj], Xs[jj + 1]);
                    }
                }
                SC_BAR();
            }
#undef SC_FENCE
#undef SC_PK2
        }
    }
}
#undef SC_BAR

struct RoRaw { u32x4 y0a, y0b, y1a, y1b, va, vb, ga, gb; float cf; };
__device__ __forceinline__ RoRaw ro_load(const bf16_t* Y, const bf16_t* V, const bf16_t* G, const float* COEF, int row, int lane) {
    const size_t e = (size_t)row * D + 16 * lane; RoRaw r;
    r.y0a = *(const u32x4*)(Y + e); r.y0b = *(const u32x4*)(Y + e + 8); r.y1a = *(const u32x4*)(Y + ACT + e); r.y1b = *(const u32x4*)(Y + ACT + e + 8);
    r.va = *(const u32x4*)(V + e); r.vb = *(const u32x4*)(V + e + 8); r.ga = *(const u32x4*)(G + e); r.gb = *(const u32x4*)(G + e + 8);
    r.cf = COEF[(size_t)row * 16 + (lane >> 2)] + COEF[(size_t)MT * 16 + (size_t)row * 16 + (lane >> 2)]; return r;
}
__device__ __forceinline__ void ro_finish(const RoRaw& r, const float* lg, const float* lb, bf16_t* Z, int row, int lane) {
    float y0[16], y1[16], v[16], g[16];
    unpack8(r.y0a, y0); unpack8(r.y0b, y0 + 8); unpack8(r.y1a, y1); unpack8(r.y1b, y1 + 8); unpack8(r.va, v); unpack8(r.vb, v + 8); unpack8(r.ga, g); unpack8(r.gb, g + 8);
    float s = 0.f;
#pragma unroll
    for (int i = 0; i < 16; ++i) { y0[i] += y1[i]; s += y0[i]; }
    const float mean = red4(s) * (1.0f / 64.0f); float qv = 0.f;
#pragma unroll
    for (int i = 0; i < 16; ++i) { y0[i] -= mean; qv += y0[i] * y0[i]; }
    const float rstd = rsqrtf(red4(qv) * (1.0f / 64.0f) + 64e-5f);
    float z[16];
#pragma unroll
    for (int i = 0; i < 16; ++i) z[i] = (y0[i] * rstd * lg[i] + lb[i] + r.cf * v[i]) * g[i];
    const size_t e = (size_t)row * D + 16 * lane;
    *(u32x4*)(Z + e) = pack8(z); *(u32x4*)(Z + e + 8) = pack8(z + 8);
}
__device__ __forceinline__ void phase_readout(const PV p, int j, const bf16_t* Y, const bf16_t* V, const bf16_t* G, const float* COEF, bf16_t* Z, int M, int gw, int ngw, int lane) {
    const float* lg = PIN(I_LNG) + j * D + 16 * lane; const float* lb = PIN(I_LNB) + j * D + 16 * lane;
    for (int row = gw; row < M; row += 2 * ngw) {
        const int row2 = row + ngw; const bool has2 = row2 < M;
        const RoRaw a = ro_load(Y, V, G, COEF, row, lane); const RoRaw b = ro_load(Y, V, G, COEF, has2 ? row2 : row, lane);
        ro_finish(a, lg, lb, Z, row, lane);
        if (has2) ro_finish(b, lg, lb, Z, row2, lane);
    }
}

__device__ __forceinline__ void gqa_head_c(float (&x)[16], const float* __restrict__ gvec, int lane8, bool rope, int gr, int gc) {
    float ss = 0.f;
#pragma unroll
    for (int i = 0; i < 16; ++i) ss += x[i] * x[i];
    const float rstd = rsqrtf(red8(ss) * (1.0f / 128.0f) + 1e-6f);
#pragma unroll
    for (int i = 0; i < 16; ++i) x[i] = x[i] * rstd * gvec[lane8 * 16 + i];
    if (rope) {
#pragma unroll
        for (int pi = 0; pi < 8; ++pi) { const int i = lane8 * 8 + pi; const int mm = i & 31; const float pos = (float)(i < 32 ? gr : gc);
            const float ang = pos * exp2f(-(float)mm * (13.287712379549449f / 32.0f)); const float c = __cosf(ang), s = __sinf(ang);
            const float x1 = x[2 * pi], x2 = x[2 * pi + 1]; x[2 * pi] = x1 * c - x2 * s; x[2 * pi + 1] = x1 * s + x2 * c; }
    }
}
__device__ __forceinline__ void phase_qknorm_gqa(const PV p, bf16_t* QKV, int gw, int ngw, int lane) {
    const float* gq = PIN(I_AGQ); const float* gk = PIN(I_AGK);
    for (int row = gw; row < MT; row += 2 * ngw) {
        const int row2 = row + ngw; const bool has2 = row2 < MT; const int r2 = has2 ? row2 : row;
        bf16_t* pa = QKV + (size_t)row * 1536 + 16 * lane; bf16_t* pb = QKV + (size_t)r2 * 1536 + 16 * lane; const bool kl = lane < 16;
        const u32x4 qa0 = *(const u32x4*)pa, qa1 = *(const u32x4*)(pa + 8), qb0 = *(const u32x4*)pb, qb1 = *(const u32x4*)(pb + 8);
        u32x4 ka0 = qa0, ka1 = qa1, kb0 = qb0, kb1 = qb1;
        if (kl) { ka0 = *(const u32x4*)(pa + 1024); ka1 = *(const u32x4*)(pa + 1032); kb0 = *(const u32x4*)(pb + 1024); kb1 = *(const u32x4*)(pb + 1032); }
        const bool latA = row < NLAT, latB = r2 < NLAT; const int tA = row & 4095, tB = r2 & 4095;
        float x[16];
        unpack8(qa0, x); unpack8(qa1, x + 8); gqa_head_c(x, gq, lane & 7, latA, tA >> 6, tA & 63); *(u32x4*)pa = pack8(x); *(u32x4*)(pa + 8) = pack8(x + 8);
        unpack8(qb0, x); unpack8(qb1, x + 8); gqa_head_c(x, gq, lane & 7, latB, tB >> 6, tB & 63); if (has2) { *(u32x4*)pb = pack8(x); *(u32x4*)(pb + 8) = pack8(x + 8); }
        if (kl) {
            unpack8(ka0, x); unpack8(ka1, x + 8); gqa_head_c(x, gk, lane & 7, latA, tA >> 6, tA & 63); *(u32x4*)(pa + 1024) = pack8(x); *(u32x4*)(pa + 1032) = pack8(x + 8);
            unpack8(kb0, x); unpack8(kb1, x + 8); gqa_head_c(x, gk, lane & 7, latB, tB >> 6, tB & 63); if (has2) { *(u32x4*)(pb + 1024) = pack8(x); *(u32x4*)(pb + 1032) = pack8(x + 8); }
        }
    }
}
__device__ __forceinline__ void na_head_c(float (&x)[16], const float* __restrict__ gvec, int lane4) {
    float ss = 0.f;
#pragma unroll
    for (int i = 0; i < 16; ++i) ss += x[i] * x[i];
    const float rstd = rsqrtf(red4(ss) * (1.0f / 64.0f) + 1e-6f);
#pragma unroll
    for (int i = 0; i < 16; ++i) x[i] = x[i] * rstd * gvec[lane4 * 16 + i];
}
__device__ __forceinline__ void phase_qknorm_na(const PV p, bf16_t* QKV, int gw, int ngw, int lane) {
    const float* gq = PIN(I_NGQ); const float* gk = PIN(I_NGK);
    for (int row = gw; row < MT; row += 2 * ngw) {
        const int row2 = row + ngw; const bool has2 = row2 < MT; const int r2 = has2 ? row2 : row;
        bf16_t* pa = QKV + (size_t)row * 3072 + 16 * lane; bf16_t* pb = QKV + (size_t)r2 * 3072 + 16 * lane;
        const u32x4 qa0 = *(const u32x4*)pa, qa1 = *(const u32x4*)(pa + 8), qb0 = *(const u32x4*)pb, qb1 = *(const u32x4*)(pb + 8);
        const u32x4 ka0 = *(const u32x4*)(pa + 1024), ka1 = *(const u32x4*)(pa + 1032), kb0 = *(const u32x4*)(pb + 1024), kb1 = *(const u32x4*)(pb + 1032);
        float x[16];
        unpack8(qa0, x); unpack8(qa1, x + 8); na_head_c(x, gq, lane & 3); *(u32x4*)pa = pack8(x); *(u32x4*)(pa + 8) = pack8(x + 8);
        unpack8(ka0, x); unpack8(ka1, x + 8); na_head_c(x, gk, lane & 3); *(u32x4*)(pa + 1024) = pack8(x); *(u32x4*)(pa + 1032) = pack8(x + 8);
        if (has2) {
            unpack8(qb0, x); unpack8(qb1, x + 8); na_head_c(x, gq, lane & 3); *(u32x4*)pb = pack8(x); *(u32x4*)(pb + 8) = pack8(x + 8);
            unpack8(kb0, x); unpack8(kb1, x + 8); na_head_c(x, gk, lane & 3); *(u32x4*)(pb + 1024) = pack8(x); *(u32x4*)(pb + 1032) = pack8(x + 8);
        }
    }
}

namespace att {
#define SBAR() __builtin_amdgcn_sched_barrier(0)
__device__ __forceinline__ int crow(int r, int hi) { return (r & 3) + 8 * (r >> 2) + 4 * hi; }
template <int HD> __device__ __forceinline__ int kswz(int row, int colB) { if constexpr (HD == 128) return row * 256 + (colB ^ ((row & 7) << 4)); else return row * 128 + (colB ^ (((row >> 1) & 7) << 4)); }
template <int HD> __device__ __forceinline__ int v_st(int k, int c) { const int kk = (k & ~0xC) | ((k & 4) << 1) | ((k & 8) >> 1); return ((kk >> 3) * (HD / 32) + (c >> 5)) * 512 + ((kk & 7) * 32 + (c & 31)) * 2; }
__device__ __forceinline__ int v_rd_base(int lane) { return ((lane & 3) << 3) | (((lane >> 2) & 3) << 6) | (((lane >> 4) & 1) << 5) | (((lane >> 5) & 1) << 8); }
template <int HD> constexpr int v_rd_off(int d0, int ks, int half) { return d0 * 512 + ks * (HD * 32) + half * (HD * 16); }
template <int OFF> __device__ __forceinline__ s16x4 tr_read(int vb) { s16x4 r; asm volatile("ds_read_b64_tr_b16 %0, %1 offset:%2" : "=&v"(r) : "v"(vb), "i"(OFF) : "memory"); return r; }

__device__ __forceinline__ void partialSM(f32x16& p0, f32x16& p1, float& m_reg, float& mn, float& alpha, const float C, const float THRS) {
    float pmax = p0[0];
#pragma unroll
    for (int r = 1; r < 16; ++r) pmax = fmaxf(pmax, p0[r]);
#pragma unroll
    for (int r = 0; r < 16; ++r) pmax = fmaxf(pmax, p1[r]);
    { auto rr = __builtin_amdgcn_permlane32_swap(__float_as_uint(pmax), __float_as_uint(pmax), false, false); pmax = fmaxf(__uint_as_float(rr[0]), __uint_as_float(rr[1])); }
    if (__builtin_expect(__all(pmax - m_reg <= THRS), 1)) { mn = m_reg; alpha = 1.f; }
    else { mn = fmaxf(m_reg, pmax); alpha = __builtin_amdgcn_exp2f((m_reg - mn) * C); m_reg = mn; }
    const float mnC = -mn * C;
#pragma unroll
    for (int r = 0; r < 16; ++r) p0[r] = fmaf(p0[r], C, mnC);
#pragma unroll
    for (int r = 0; r < 16; ++r) p1[r] = fmaf(p1[r], C, mnC);
#pragma unroll
    for (int r = 0; r < 16; ++r) p0[r] = __builtin_amdgcn_exp2f(p0[r]);
}
__device__ __forceinline__ void finishSM(f32x16& p0, f32x16& p1, float alpha, float& l_reg, bf16x8& pa0, bf16x8& pa1, bf16x8& pa2, bf16x8& pa3) {
#pragma unroll
    for (int r = 0; r < 16; ++r) p1[r] = __builtin_amdgcn_exp2f(p1[r]);
    float ps = 0;
#pragma unroll
    for (int r = 0; r < 16; ++r) ps += p0[r];
#pragma unroll
    for (int r = 0; r < 16; ++r) ps += p1[r];
    { auto rr = __builtin_amdgcn_permlane32_swap(__float_as_uint(ps), __float_as_uint(ps), false, false); ps = __uint_as_float(rr[0]) + __uint_as_float(rr[1]); }
    l_reg = l_reg * alpha + ps;
#define PK4(P, BASE, OUT) do { unsigned a0 = cvt_pk_bf16(P[BASE + 0], P[BASE + 1]), a1 = cvt_pk_bf16(P[BASE + 2], P[BASE + 3]);   \
    unsigned b0 = cvt_pk_bf16(P[BASE + 4], P[BASE + 5]), b1 = cvt_pk_bf16(P[BASE + 6], P[BASE + 7]);                              \
    auto r0 = __builtin_amdgcn_permlane32_swap(a0, b0, false, false); auto r1 = __builtin_amdgcn_permlane32_swap(a1, b1, false, false); \
    u32x4 w = {r0[0], r1[0], r0[1], r1[1]}; OUT = *reinterpret_cast<bf16x8*>(&w); } while (0)
    PK4(p0, 0, pa0); PK4(p0, 8, pa1); PK4(p1, 0, pa2); PK4(p1, 8, pa3);
#undef PK4
}
template <int HD> __device__ __forceinline__ void qkt(f32x16& p0, f32x16& p1, const char* Ks, const bf16x8* qr, int r32, int hi) {
    p0 = f32x16{}; p1 = f32x16{};
#pragma unroll
    for (int d0 = 0; d0 < HD / 16; ++d0) { const int cb = (d0 * 16 + hi * 8) * 2;
        const bf16x8 b0 = *reinterpret_cast<const bf16x8*>(Ks + kswz<HD>(r32, cb));
        const bf16x8 b1 = *reinterpret_cast<const bf16x8*>(Ks + kswz<HD>(32 + r32, cb));
        p0 = __builtin_amdgcn_mfma_f32_32x32x16_bf16(b0, qr[d0], p0, 0, 0, 0);
        p1 = __builtin_amdgcn_mfma_f32_32x32x16_bf16(b1, qr[d0], p1, 0, 0, 0); }
}
template <int HD, int D0> __device__ __forceinline__ void pv_one(f32x16& od, int vb, bf16x8 pa0, bf16x8 pa1, bf16x8 pa2, bf16x8 pa3) {
    const s16x4 l0 = tr_read<v_rd_off<HD>(D0, 0, 0)>(vb), h0 = tr_read<v_rd_off<HD>(D0, 0, 1)>(vb), l1 = tr_read<v_rd_off<HD>(D0, 1, 0)>(vb), h1 = tr_read<v_rd_off<HD>(D0, 1, 1)>(vb);
    const s16x4 l2 = tr_read<v_rd_off<HD>(D0, 2, 0)>(vb), h2 = tr_read<v_rd_off<HD>(D0, 2, 1)>(vb), l3 = tr_read<v_rd_off<HD>(D0, 3, 0)>(vb), h3 = tr_read<v_rd_off<HD>(D0, 3, 1)>(vb);
    asm volatile("s_waitcnt lgkmcnt(0)" ::: "memory"); SBAR();
#define PK(L, H) (bf16x8){L[0], L[1], L[2], L[3], H[0], H[1], H[2], H[3]}
    od = __builtin_amdgcn_mfma_f32_32x32x16_bf16(pa0, PK(l0, h0), od, 0, 0, 0);
    od = __builtin_amdgcn_mfma_f32_32x32x16_bf16(pa1, PK(l1, h1), od, 0, 0, 0);
    od = __builtin_amdgcn_mfma_f32_32x32x16_bf16(pa2, PK(l2, h2), od, 0, 0, 0);
    od = __builtin_amdgcn_mfma_f32_32x32x16_bf16(pa3, PK(l3, h3), od, 0, 0, 0);
#undef PK
}
template <int HD> __device__ __forceinline__ void pv_d0(f32x16* o, int vb, bf16x8 pa0, bf16x8 pa1, bf16x8 pa2, bf16x8 pa3) {
    pv_one<HD, 0>(o[0], vb, pa0, pa1, pa2, pa3); pv_one<HD, 1>(o[1], vb, pa0, pa1, pa2, pa3);
    if constexpr (HD == 128) { pv_one<HD, 2>(o[2], vb, pa0, pa1, pa2, pa3); pv_one<HD, 3>(o[3], vb, pa0, pa1, pa2, pa3); }
}
__device__ __forceinline__ void na_mask(f32x16& p0, f32x16& p1, const float* btab, int kr, int rq, int c, int hi) {
    const int rs = min(max(rq - 4, 0), 56), cs = min(max(c - 8, 0), 48);
    const bool rowok = (kr >= rs) && (kr < rs + 8);
    const float* brow = btab + (kr - rq + 7) * 31 - c + 15;
#pragma unroll
    for (int r = 0; r < 16; ++r) { const int kc = crow(r, hi);
        const bool ok0 = rowok && ((unsigned)(kc - cs) < 16u), ok1 = rowok && ((unsigned)(kc + 32 - cs) < 16u);
        p0[r] = ok0 ? p0[r] + brow[kc] : -1e30f; p1[r] = ok1 ? p1[r] + brow[kc + 32] : -1e30f; }
}
template <int HD, int LDI, bool NA>
__device__ __forceinline__ void attn_unit(const bf16_t* __restrict__ Qb, const bf16_t* __restrict__ Kc, const bf16_t* __restrict__ Vc, int rowA, int nA, int rowB, int NT,
                                          bf16_t* __restrict__ Ob, char* lds, const float SCALE, const float* rpb_h, int r0, int kstart, int nmask0) {
    constexpr int SHM = 64 * HD * 2, NO = HD / 32, NQ = HD / 16;
    const float C = SCALE * 1.4426950408889634f, THRS = 8.f / SCALE;
    const int tid = opq((int)threadIdx.x), wid = tid >> 6, lane = tid & 63, r32 = lane & 31, hi = lane >> 5;
    char* V_lds = lds; char* K_lds = lds + 2 * SHM;
    float* ws = (float*)(lds + 4 * SHM) + wid * 64; float* li_l = ws; float* al_l = ws + 32;
    float* btab = (float*)(lds + 4 * SHM + 8 * 256);
    __syncthreads();
    if constexpr (NA) { if (rpb_h) { for (int i = tid; i < 465; i += 512) btab[i] = rpb_h[i] * (1.0f / SCALE); } }
    float m_reg = -1e30f, l_reg = 0; f32x16 o[NO]; bf16x8 qr[NQ];
#pragma unroll
    for (int d = 0; d < NO; ++d) o[d] = f32x16{};
    const bf16_t* Qw = Qb + (size_t)(wid * 32 + r32) * LDI + hi * 8;
#pragma unroll
    for (int d0 = 0; d0 < NQ; ++d0) qr[d0] = *reinterpret_cast<const bf16x8*>(Qw + d0 * 16);
    constexpr int TPR = HD / 8;
    const int sr = tid / TPR, sc = (tid % TPR) * 8;
    const int vst0 = v_st<HD>(sr, sc), vst1 = v_st<HD>(32 + sr, sc);
    const int kst0 = kswz<HD>(sr, sc * 2), kst1 = kswz<HD>(32 + sr, sc * 2);
    const int vb0 = (int)(uintptr_t)V_lds + v_rd_base(lane);
    const int rq = r0 + (wid >> 1), cq = (wid & 1) * 32 + r32;
    bf16x8 s0v0, s0v1, s0k0, s0k1, s1v0, s1v1, s1k0, s1k1;
#define TROW(j) ((j) < nA ? rowA + 64 * (j) : rowB + 64 * ((j) - nA))
#define SLOAD(V0, V1, K0, K1, j) do { const size_t g_ = (size_t)(TROW(j) + sr) * LDI + sc; V0 = *reinterpret_cast<const bf16x8*>(Vc + g_); K0 = *reinterpret_cast<const bf16x8*>(Kc + g_); \
        if constexpr (HD == 128) { V1 = *reinterpret_cast<const bf16x8*>(Vc + g_ + (size_t)32 * LDI); K1 = *reinterpret_cast<const bf16x8*>(Kc + g_ + (size_t)32 * LDI); } } while (0)
#define SWRITE(b, V0, V1, K0, K1) do { *(bf16x8*)(V_lds + (b) * SHM + vst0) = V0; *(bf16x8*)(K_lds + (b) * SHM + kst0) = K0; \
        if constexpr (HD == 128) { *(bf16x8*)(V_lds + (b) * SHM + vst1) = V1; *(bf16x8*)(K_lds + (b) * SHM + kst1) = K1; } } while (0)
#define RESC(a) do { if (__any((a) < 1.f)) { if (hi == 0) al_l[r32] = (a); asm volatile("s_waitcnt lgkmcnt(0)" ::: "memory"); \
        _Pragma("unroll") for (int d = 0; d < NO; ++d) _Pragma("unroll") for (int r = 0; r < 16; ++r) o[d][r] *= al_l[crow(r, hi)]; } } while (0)
#define MASK(P0, P1, j) do { if constexpr (NA) { if ((j) >= nmask0) na_mask(P0, P1, btab, kstart + (j) - nmask0, rq, cq, hi); } } while (0)
    f32x16 pA0, pA1, pB0, pB1; float mnA, mnB, alA, alB; bf16x8 pa0, pa1, pa2, pa3;
    const int rsq_ = __builtin_amdgcn_readfirstlane(min(max(rq - 4, 0), 56));
#define ROWOK(j) (!NA || (j) < nmask0 || ((unsigned)(kstart + (j) - nmask0 - rsq_) < 8u))
#define QKT(P0, P1, OK, KP, j) do { OK = ROWOK(j); if (OK) qkt<HD>(P0, P1, KP, qr, r32, hi); } while (0)
#define PSM(P0, P1, OK, MN, AL, j) do { if (OK) { MASK(P0, P1, j); partialSM(P0, P1, m_reg, MN, AL, C, THRS); } else { MN = m_reg; AL = 1.f; } } while (0)
#define FSM(P0, P1, OK, AL) do { if (OK) finishSM(P0, P1, AL, l_reg, pa0, pa1, pa2, pa3); } while (0)
#define PVD(VB, OK) do { if (OK) pv_d0<HD>(o, VB, pa0, pa1, pa2, pa3); } while (0)
    bool okA = true, okB = true;
    SLOAD(s0v0, s0v1, s0k0, s0k1, 0); SWRITE(0, s0v0, s0v1, s0k0, s0k1); __syncthreads();
    QKT(pA0, pA1, okA, K_lds, 0); PSM(pA0, pA1, okA, mnA, alA, 0);
    SLOAD(s1v0, s1v1, s1k0, s1k1, 1); if (2 < NT) SLOAD(s0v0, s0v1, s0k0, s0k1, 2);
    SWRITE(1, s1v0, s1v1, s1k0, s1k1); __syncthreads();
    for (int j = 1; j + 1 < NT; j += 2) {
        SBAR(); QKT(pB0, pB1, okB, K_lds + SHM, j);
        FSM(pA0, pA1, okA, alA); SBAR();
        SLOAD(s1v0, s1v1, s1k0, s1k1, j + 2); SBAR();
        PVD(vb0, okA); PSM(pB0, pB1, okB, mnB, alB, j);
        __syncthreads(); SWRITE(0, s0v0, s0v1, s0k0, s0k1);
        RESC(alB); __syncthreads();
        SBAR(); QKT(pA0, pA1, okA, K_lds, j + 1);
        FSM(pB0, pB1, okB, alB); SBAR();
        if (j + 3 < NT) SLOAD(s0v0, s0v1, s0k0, s0k1, j + 3); SBAR();
        PVD(vb0 + SHM, okB); PSM(pA0, pA1, okA, mnA, alA, j + 1);
        __syncthreads(); SWRITE(1, s1v0, s1v1, s1k0, s1k1);
        RESC(alA); __syncthreads();
    }
    SBAR(); QKT(pB0, pB1, okB, K_lds + SHM, NT - 1);
    FSM(pA0, pA1, okA, alA); SBAR();
    PVD(vb0, okA); PSM(pB0, pB1, okB, mnB, alB, NT - 1);
    __syncthreads(); RESC(alB);
    FSM(pB0, pB1, okB, alB); SBAR();
    PVD(vb0 + SHM, okB);
    if (hi == 0) li_l[r32] = l_reg; asm volatile("s_waitcnt lgkmcnt(0)" ::: "memory");
    float rli[16];
#pragma unroll
    for (int r = 0; r < 16; ++r) rli[r] = __builtin_amdgcn_rcpf(li_l[crow(r, hi)]);
    bf16_t* Ow = Ob + (size_t)(wid * 32) * 1024;
#pragma unroll
    for (int r = 0; r < 16; ++r) { const int orow = crow(r, hi);
#pragma unroll
        for (int d0 = 0; d0 < NO; ++d0) { const float val = o[d0][r] * rli[r]; Ow[(size_t)orow * 1024 + d0 * 32 + r32] = (bf16_t)(cvt_pk_bf16(val, val) & 0xffffu); } }
#undef TROW
#undef SLOAD
#undef SWRITE
#undef RESC
#undef MASK
#undef ROWOK
#undef QKT
#undef PSM
#undef FSM
#undef PVD
}
#undef SBAR
}

__device__ __forceinline__ void phase_attn_gqa(bf16_t* QKV, bf16_t* O, char* lds) {
    const int G = gridDim.x, bid = blockIdx.x;
    for (int i = 0; ; ++i) {
        int b, hq, qb; bool ctxu = false;
        if (G == 256) { const int x = bid & 7, k = bid >> 3;
            if (i < 2) { const int ug = i * 32 + k; b = x >> 1; hq = (x & 1) * 4 + (ug >> 4); qb = ug & 15; }
            else if (i == 2 && bid < 32) { ctxu = true; hq = bid & 7; b = bid >> 3; qb = 0; } else break;
        } else { const int u = bid + i * G; if (u >= 544) break;
            if (u < 512) { qb = u & 15; hq = (u >> 4) & 7; b = u >> 7; } else { ctxu = true; const int v = u - 512; hq = v & 7; b = v >> 3; qb = 0; } }
        const int kvh = hq >> 2, row0 = ctxu ? NLAT + b * CTXL : b * SEQ + qb * 256;
        const int rowA = ctxu ? NLAT + b * CTXL : b * SEQ, nA = ctxu ? 4 : 64, rowB = NLAT + b * CTXL, NT = ctxu ? 4 : 68;
        att::attn_unit<128, 1536, false>(QKV + (size_t)row0 * 1536 + hq * 128, QKV + 1024 + kvh * 128, QKV + 1280 + kvh * 128, rowA, nA, rowB, NT,
                                         O + (size_t)row0 * 1024 + hq * 128, lds, 0.08838834764831845f, nullptr, 0, 0, 1 << 30);
    }
}
__device__ __forceinline__ void phase_attn_na(const PV p, bf16_t* QKV, bf16_t* O, char* lds) {
    const int G = gridDim.x, bid = blockIdx.x;
    const float* rpb = PIN(I_RPB);
    for (int i = 0; ; ++i) {
        int b, h, rg; bool ctxu = false;
        if (G == 256) { const int x = bid & 7, k = bid >> 3;
            if (i < 4) { const int ug = i * 32 + k, grp = x + 8 * (ug >> 4); b = grp >> 4; h = grp & 15; rg = ug & 15; }
            else if (i == 4 && bid < 64) { ctxu = true; h = bid & 15; b = bid >> 4; rg = 0; } else break;
        } else { const int u = bid + i * G; if (u >= 1088) break;
            if (u < 1024) { rg = u & 15; h = (u >> 4) & 15; b = u >> 8; } else { ctxu = true; const int v = u - 1024; h = v & 15; b = v >> 4; rg = 0; } }
        const int r0 = rg * 4, kstart = min(max(r0 - 4, 0), 52);
        const int row0 = ctxu ? NLAT + b * CTXL : b * SEQ + rg * 256, rowA = NLAT + b * CTXL, rowB = b * SEQ + kstart * 64, NT = ctxu ? 4 : 16;
        att::attn_unit<64, 3072, true>(QKV + (size_t)row0 * 3072 + h * 64, QKV + 1024 + h * 64, QKV + 2048 + h * 64, rowA, 4, rowB, NT,
                                       O + (size_t)row0 * 1024 + h * 64, lds, 0.125f, ctxu ? nullptr : rpb + h * 465, r0, kstart, ctxu ? (1 << 30) : 4);
    }
}

template <class Epi> __device__ __forceinline__ void run_gemm(LAS unsigned char* lds, const bf16_t* A, const bf16_t* Bt, int M, int N, int K, int lda, int mode, const Epi& E) {
    pg8::Gemm g{A, Bt, M, N, K, lda}; pg8::GenOrder S; S.init(M, N, K, (int)gridDim.x, (int)blockIdx.x, mode); S.caoff = (long)((WS_C - WS_A) / 2); S.act = (long)ACT;
    pg8::gemm_phase<Epi, pg8::GenOrder, true, true>(lds, g, S, E);
}

#define RLX_AGENT __ATOMIC_RELAXED, __HIP_MEMORY_SCOPE_AGENT
#define XB_TMO      128
#define XB_XCNT(j)  (256  + 64 * (j))
#define XB_XSUB(j)  (1280 + 64 * (j))
#define XB_XGEN(j)  (2304 + 64 * (j))
#define XB_TOP      3328
#define XB_TOPGEN   3392
#define XCD_BAR_WORDS 3456
#define XB_SPIN_CAP (1u << 18)

__device__ __forceinline__ unsigned xb_ld(unsigned* p)              { return __hip_atomic_load(p, __ATOMIC_RELAXED, __HIP_MEMORY_SCOPE_AGENT); }
__device__ __forceinline__ unsigned xb_add(unsigned* p, unsigned v) { return __hip_atomic_fetch_add(p, v, __ATOMIC_RELAXED, __HIP_MEMORY_SCOPE_AGENT); }
__device__ __forceinline__ unsigned xb_xcc_id() { return (unsigned)__builtin_amdgcn_s_getreg((3 << 11) | 20) & 0xFu; }
#define XB_SPIN(cond, bar) do { unsigned _sp = 0; while (cond) { __builtin_amdgcn_s_sleep(1); \
    if ((++_sp & 255u) == 0u) { if (xb_ld(&(bar)[XB_TMO])) break; if (_sp > XB_SPIN_CAP) { atomicAdd(&(bar)[XB_TMO], 1u); break; } } } } while (0)

struct XcdBarrier {
    unsigned* bar; unsigned x;
    volatile LAS unsigned* st;
};

__device__ __forceinline__ XcdBarrier xcd_barrier_post(unsigned* bar, volatile LAS unsigned* st) {
    XcdBarrier b; b.bar = bar; b.x = xb_xcc_id(); b.st = st;
    if (threadIdx.x == 0) (void)xb_add(&bar[XB_XCNT(b.x)], 1u);
    return b;
}
__device__ __forceinline__ void xcd_barrier_complete(unsigned* bar, unsigned x, unsigned& nloc, unsigned& nx) {
    const unsigned G = gridDim.x * gridDim.y * gridDim.z;
    unsigned sum, cnt, mine, sp = 0u;
    for (;;) {
        sum = 0u; cnt = 0u; mine = 0u;
#pragma unroll
        for (unsigned j = 0; j < 16; ++j) { const unsigned c = xb_ld(&bar[XB_XCNT(j)]); sum += c; cnt += (c > 0u) ? 1u : 0u; mine = (j == x) ? c : mine; }
        if (sum == G) break;
        __builtin_amdgcn_s_sleep(1);
        if ((++sp & 255u) == 0u) { if (xb_ld(&bar[XB_TMO])) break; if (sp > XB_SPIN_CAP) { atomicAdd(&bar[XB_TMO], 1u); break; } }
    }
    nloc = mine > 0u ? mine : 1u; nx = cnt > 0u ? cnt : 1u;
}

__device__ __forceinline__ void xcd_barrier(const XcdBarrier& b) {
    asm volatile("s_waitcnt vmcnt(0)" ::: "memory");
    __syncthreads();
    if (threadIdx.x == 0) {
        unsigned* bar = b.bar;
        __builtin_amdgcn_s_waitcnt(0);
        unsigned nloc = b.st[0], nx = b.st[1];
        if (nloc == 0u) { xcd_barrier_complete(bar, b.x, nloc, nx); b.st[0] = nloc; b.st[1] = nx; }
        const unsigned old = xb_add(&bar[XB_XSUB(b.x)], 1u);
        const unsigned gen = old / nloc;
        if (old + 1u == (gen + 1u) * nloc) {
            __builtin_amdgcn_fence(__ATOMIC_RELEASE, "agent");
            asm volatile("s_waitcnt vmcnt(0)" ::: "memory");
            const unsigned og = xb_add(&bar[XB_TOP], 1u);
            const unsigned tg = og / nx;
            if (og + 1u == (tg + 1u) * nx) xb_add(&bar[XB_TOPGEN], 1u);
            else XB_SPIN(xb_ld(&bar[XB_TOPGEN]) == tg, bar);
            __builtin_amdgcn_fence(__ATOMIC_ACQUIRE, "agent");
            xb_add(&bar[XB_XGEN(b.x)], 1u);
            asm volatile("s_waitcnt vmcnt(0)" ::: "memory");
        } else {
            XB_SPIN(xb_ld(&bar[XB_XGEN(b.x)]) == gen, bar);
            __builtin_amdgcn_fence(__ATOMIC_ACQUIRE, "agent");
            asm volatile("s_waitcnt vmcnt(0)" ::: "memory");
        }
    }
    __syncthreads();
}

constexpr size_t WS_BAR = 768 * 1024;
constexpr int LDS_BARST = LDS_BYTES - 64;
#ifndef PROBE_KIND
#define PROBE_KIND 0
#endif
__device__ __forceinline__ bool probe_hit(int ph) {
    int L = 0, s = -1;
    if (ph >= 1) { const int q = ph - 1; if (q < 9) { L = 0; s = q; } else if (q < 17) { L = 1; s = q - 9; } else if (q < 25) { L = 2; s = q - 17; } else { L = 3; s = q - 25; } }
    const bool rw = (L == 0 || L == 3);
    if (PROBE_KIND == 1) return rw && s == 3;
    if (PROBE_KIND == 2) return !rw && s == 3;
    if (PROBE_KIND == 3) return rw && (s == 1 || s == 2);
    if (PROBE_KIND == 4) return (s == 0) || (rw && s == 6) || (!rw && s == 5);
    if (PROBE_KIND == 5) return (rw && s == 7) || (!rw && s == 6);
    if (PROBE_KIND == 6) return (rw && s == 4) || (!rw && s == 2) || ph == 0;
    return false;
}
__device__ __forceinline__ unsigned char* wsq_() { int z; asm volatile("s_mov_b32 %0, 0" : "=s"(z)); return (unsigned char*)pin(41, z); }
__device__ __forceinline__ unsigned char* obq_() { int z; asm volatile("s_mov_b32 %0, 0" : "=s"(z)); return (unsigned char*)pin(40, z); }
#define WSQ (wsq_())
#define OBQ (obq_())
#define Q_MOD ((float*)(WSQ + WS_MOD))
#define Q_H ((float*)(WSQ + WS_H))
#define Q_RA ((bf16_t*)(WSQ + WS_A))
#define Q_RB ((bf16_t*)(WSQ + WS_B))
#define Q_RC ((bf16_t*)(WSQ + WS_C))
#define QR_W1b ((bf16_t*)(OBQ + 34 * MiB))
#define QR_HL ((bf16_t*)(OBQ + 48 * MiB))
#define QR_G ((bf16_t*)OBQ)
#define QR_W2b ((bf16_t*)(WSQ + WS_S))
#define QR_Wo ((bf16_t*)(WSQ + WS_S + 3840 * 1024))
#define QR_COEF ((float*)(WSQ + WS_S + 6 * MiB))
#define QR_W2t ((bf16_t*)(WSQ + WS_B + 11 * MiB))
#define QA_Wqkv ((bf16_t*)(WSQ + WS_ATTW))
#define QA_Wo ((bf16_t*)(WSQ + WS_ATTW + 6 * MiB))
#define QA_W13 ((bf16_t*)(WSQ + WS_ATTW + 8 * MiB))
#define QA_W2t ((bf16_t*)(WSQ + WS_ATTW + 19 * MiB))
__global__ void __launch_bounds__(512, 2) mega(Params kp) {
    extern __shared__ __attribute__((aligned(16))) unsigned char lds_raw[];
    LAS unsigned char* lds = (LAS unsigned char*)lds_raw;
    const int ph_lo = kp.ph_lo, ph_hi = kp.ph_hi;
    if (ph_hi - ph_lo > 1) {
        if (threadIdx.x < 2) ((LAS unsigned*)(lds + LDS_BARST))[threadIdx.x] = 0u;
        __syncthreads();
        (void)xcd_barrier_post((unsigned*)(kp.ws + WS_BAR), (volatile LAS unsigned*)(lds + LDS_BARST));
    }
#if PROBE_KIND
    int rep = 0;
#endif
    for (int ph = ph_lo; ph < ph_hi; ++ph) {
        PV p; asm volatile("s_mov_b32 %0, 0" : "=s"(p.z));
#define WIDS const int tid_ = opq((int)threadIdx.x); const int lane = tid_ & 63; const int gw = blockIdx.x * 8 + (tid_ >> 6); const int ngw = gridDim.x * 8;
        int L = 0, s = 0;
        if (ph >= 1) { const int q = ph - 1; if (q < 9) { L = 0; s = q; } else if (q < 17) { L = 1; s = q - 9; } else if (q < 25) { L = 2; s = q - 17; } else { L = 3; s = q - 25; } }
        int gsel = 0; const bf16_t* gA = nullptr; const bf16_t* gB = nullptr; int gM = 0, gN = 0, gK = 0, gmode = 0;
        pg8::EpiStore es; es.O = nullptr; es.ldc = 0; es.split_cols = 0; es.split_stride = 0; es.Oalt = nullptr; es.talt = -1; es.HL = nullptr; es.rw1 = 0;
        pg8::EpiRes er; er.base_lat = nullptr; er.base_ctx = nullptr; er.out = nullptr; er.gate = nullptr; er.part = (float*)(WSQ + WS_B + 20 * MiB);
        const float* PART = (const float*)(WSQ + WS_B + 20 * MiB);
        pg8::EpiSwiglu eg; eg.U = nullptr; eg.ldu = DFF;
        const float* modl = Q_MOD + (size_t)L * 5 * 6144;
        if (ph == 0) {
            phase_mod(p, (LAS float*)lds, Q_MOD);
        } else if (L == 0 || L == 3) {
            const int j = (L == 3) ? 1 : 0; const int Mr = (L < 3) ? MT : NLAT;
            switch (s) {
            case 0: { WIDS; cvt_rwkv_mixer(p, j, QR_W1b, QR_W2b, QR_Wo, gw, ngw, lane);
                    const float* hb_lat = (L == 0) ? PIN(I_X) : Q_H; const float* hb_ctx = (L == 0) ? (PIN(I_CTX) - (size_t)NLAT * D) : Q_H;
                    if (L == 0) { const float* cx = PIN(I_CTX); for (int i = gw * 64 + lane; i < NCTX * D / 4; i += ngw * 64) ((f32x4*)(Q_H + (size_t)NLAT * D))[i] = ((const f32x4*)cx)[i]; }
                    phase_norm_shift(hb_lat, hb_ctx, PIN(I_NMIX) + L * D, modl, PIN(I_MU) + (size_t)j * 6 * D, Q_RA, Q_RC, gw, ngw, lane); } break;
            case 1: gsel = 1; gA = Q_RA; gB = QR_W1b; gM = MT; gN = 3840; gK = 1024; gmode = 1; es.O = Q_RB; es.ldc = 1024; es.split_cols = 1024; es.split_stride = ACT; es.HL = QR_HL; es.rw1 = 1; break;
            case 2: gsel = 1; gA = QR_HL; gB = QR_W2b; gM = MT; gN = 5120; gK = 384; gmode = 3; es.O = Q_RC; es.ldc = 1024; es.split_cols = 1024; es.split_stride = ACT; es.Oalt = QR_G; es.talt = 4; break;
#ifndef NO_SCAN
            case 3: phase_scan(p, j, lds, Q_RB, (Q_RB + ACT), (Q_RB + 2 * ACT), Q_RC, Q_RC + 2 * ACT, Q_RA, QR_COEF); break;
#endif
            case 4: { WIDS; cvt_ffn(p, L, Q_RB, QR_W2t, gw, ngw, lane);
                    phase_readout(p, j, Q_RA, (Q_RB + 2 * ACT), QR_G, QR_COEF, Q_RC, Mr, gw, ngw, lane); } break;
            case 5: gsel = 2; gA = Q_RC; gB = QR_Wo; gM = Mr; gN = 1024; gK = 1024; gmode = 2; er.base_lat = (L == 0) ? PIN(I_X) : Q_H; er.base_ctx = (L == 0) ? (PIN(I_CTX) - (size_t)NLAT * D) : Q_H; er.out = Q_H; er.gate = modl + 2048; break;
            case 6: { WIDS; phase_norm(Q_H, Q_H, PIN(I_NFFN) + L * D, modl, 3072, 4096, Q_RA, Mr, gw, ngw, lane, Q_H, PART, (L < 3) ? 4 : 0); } break;
            case 7: gsel = 3; gA = Q_RA; gB = Q_RB; gM = Mr; gN = 5632; gK = 1024; eg.U = Q_RC; break;
            default: gsel = 2; gA = Q_RC; gB = QR_W2t; gM = Mr; gN = 1024; gK = DFF; gmode = (L == 0) ? 2 : 0; er.base_lat = Q_H; er.base_ctx = Q_H; er.out = (L == 3) ? (float*)OBQ : Q_H; er.gate = modl + 5120; break;
            }
        } else {
            const bool gqa = (L == 1); const int NQ = gqa ? 1536 : 3072;
            switch (s) {
            case 0: { WIDS; int gwc = gw;
                if (gqa) { cvt_run(mkjob(PIN(I_AWQ), nullptr, QA_Wqkv, D, 1024, 1024, 0, 0, 0), gwc, ngw, lane); cvt_run(mkjob(PIN(I_AWK), nullptr, QA_Wqkv, D, 256, 1024, 0, 1024, 0), gwc, ngw, lane);
                           cvt_run(mkjob(PIN(I_AWV), nullptr, QA_Wqkv, D, 256, 1024, 0, 1280, 0), gwc, ngw, lane); cvt_run(mkjob(PIN(I_AWO), nullptr, QA_Wo, D, D, 1024, 0, 0, 0), gwc, ngw, lane); }
                else { cvt_run(mkjob(PIN(I_NWQKV), nullptr, QA_Wqkv, D, 3072, 1024, 0, 0, 0), gwc, ngw, lane); cvt_run(mkjob(PIN(I_NWO), nullptr, QA_Wo, D, D, 1024, 0, 0, 0), gwc, ngw, lane); }
                cvt_ffn(p, L, QA_W13, QA_W2t, gw, ngw, lane);
                phase_norm(Q_H, Q_H, PIN(I_NMIX) + L * D, modl, 0, 1024, Q_RA, MT, gw, ngw, lane, Q_H, PART, 11); } break;
            case 1: gsel = 1; gA = Q_RA; gB = QA_Wqkv; gM = MT; gN = NQ; gK = 1024; es.O = Q_RB; es.ldc = NQ; break;
            case 2: { WIDS; if (gqa) phase_qknorm_gqa(p, Q_RB, gw, ngw, lane); else phase_qknorm_na(p, Q_RB, gw, ngw, lane); } break;
#ifndef NO_ATT
            case 3: if (gqa) phase_attn_gqa(Q_RB, (Q_RA + ACT), (char*)lds_raw); else phase_attn_na(p, Q_RB, (Q_RA + ACT), (char*)lds_raw); break;
#endif
            case 4: gsel = 2; gA = (Q_RA + ACT); gB = QA_Wo; gM = MT; gN = 1024; gK = 1024; gmode = 2; er.base_lat = Q_H; er.base_ctx = Q_H; er.out = Q_H; er.gate = modl + 2048; break;
            case 5: { WIDS; phase_norm(Q_H, Q_H, PIN(I_NFFN) + L * D, modl, 3072, 4096, Q_RA, MT, gw, ngw, lane, Q_H, PART, 4); } break;
            case 6: gsel = 3; gA = Q_RA; gB = QA_W13; gM = MT; gN = 5632; gK = 1024; eg.U = Q_RC; break;
            default: gsel = 2; gA = Q_RC; gB = QA_W2t; gM = MT; gN = 1024; gK = DFF; gmode = (L == 1) ? 2 : 0; er.base_lat = Q_H; er.base_ctx = Q_H; er.out = Q_H; er.gate = modl + 5120; break;
            }
        }
#ifndef NO_GEMM
        if (gsel == 1) run_gemm<pg8::EpiStore>(lds, gA, gB, gM, gN, gK, gK, gmode, es);
        else if (gsel == 2) run_gemm<pg8::EpiRes>(lds, gA, gB, gM, gN, gK, gK, gmode, er);
        else if (gsel == 3) run_gemm<pg8::EpiSwiglu>(lds, gA, gB, gM, gN, gK, gK, gmode, eg);
#endif
#if PROBE_KIND
        if (rep == 0 && probe_hit(ph)) { rep = 1; cg::this_grid().sync(); --ph; continue; }
        rep = 0;
#endif
        if (ph + 1 < ph_hi) { if (ph_lo < 0) cg::this_grid().sync(); else { XcdBarrier bar; bar.bar = (unsigned*)(WSQ + WS_BAR); bar.x = xb_xcc_id(); bar.st = (volatile LAS unsigned*)(lds + LDS_BARST); xcd_barrier(bar); } }
    }
}

extern "C" void kernel_launch(void* const* d_in, const int* in_sizes, int n_in, void* d_out, int out_size, void* d_ws, size_t ws_size, hipStream_t stream) {
    static int grid = 0;
    if (grid == 0) {
        if (n_in != 40 || out_size != NLAT * D || ws_size < WS_END) { fprintf(stderr, "kernel_launch: unexpected shapes: n_in %d out %d ws %zu (need >= %zu)\n", n_in, out_size, ws_size, (size_t)WS_END); grid = -1; return; }
        int dev = 0, cus = 0, per_cu = 0;
        if (hipGetDevice(&dev) != hipSuccess || hipDeviceGetAttribute(&cus, hipDeviceAttributeMultiprocessorCount, dev) != hipSuccess) { grid = -1; return; }
        if (hipFuncSetAttribute((const void*)mega, hipFuncAttributeMaxDynamicSharedMemorySize, LDS_BYTES) != hipSuccess) { fprintf(stderr, "kernel_launch: hipFuncSetAttribute failed\n"); grid = -1; return; }
        if (hipOccupancyMaxActiveBlocksPerMultiprocessor(&per_cu, (const void*)mega, 512, LDS_BYTES) != hipSuccess || per_cu < 1) { fprintf(stderr, "kernel_launch: occupancy query gave %d\n", per_cu); per_cu = 1; }
        (void)hipGetLastError();
        grid = cus * per_cu;
    }
    if (grid < 0) return;
    Params p{};
    for (int i = 0; i < 40; ++i) p.in[i] = (const float*)d_in[i];
    p.out = (float*)d_out; p.ws = (unsigned char*)d_ws;
#if ONE_LAUNCH
    p.ph_lo = 0; p.ph_hi = NPH;
    if (hipMemsetAsync((char*)d_ws + WS_BAR, 0, XCD_BAR_WORDS * 4, stream) != hipSuccess) { fprintf(stderr, "kernel_launch: hipMemsetAsync of the barrier words failed\n"); return; }
    void* args[] = {&p};
    hipError_t e = hipLaunchCooperativeKernel((const void*)mega, dim3(grid), dim3(512), args, LDS_BYTES, stream);
    if (e != hipSuccess) fprintf(stderr, "cooperative launch failed: %s (grid %d)\n", hipGetErrorString(e), grid);
#else
    for (int ph = 0; ph < NPH; ++ph) { p.ph_lo = ph; p.ph_hi = ph + 1; hipLaunchKernelGGL(mega, dim3(grid), dim3(512), LDS_BYTES, stream, p); }
#endif
}
```
